# Optimizing an MI355X kernel written in HIP

```python
import math
import jax, jax.numpy as jnp
from jax import lax
import numpy as np

D_MODEL = 2048
BATCH = 4
SEQ = 4096
DEPTH = 4

N_EVEN = (DEPTH + 1) // 2
N_ODD = DEPTH // 2
RWKV_WIDTH = D_MODEL // 2
RWKV_HEAD = 64
RWKV_HEADS = RWKV_WIDTH // RWKV_HEAD
RWKV_LORA = 64
S5_WIDTH = D_MODEL // 2
S5_GROUP = 16
S5_GROUPS = S5_WIDTH // S5_GROUP
S5_STATE = 64
A_IN = 4 * RWKV_WIDTH + 2 * RWKV_LORA
B_IN = 2 * S5_WIDTH
EVEN_IN = A_IN + B_IN
EVEN_MIX = RWKV_WIDTH + S5_WIDTH
MLA_HEADS = 16
QK_NOPE = 128
QK_ROPE = 64
V_HEAD = 128
Q_LORA = 512
KV_LORA = 512
MLA_WIDTH = MLA_HEADS * V_HEAD
ODD_IN = Q_LORA + KV_LORA + QK_ROPE + MLA_WIDTH
ROPE_BASE = 10000.0
Q_BLOCK = 128
NORM_EPS = 1e-6
LNX_EPS = 64e-5

kernel_name = 'hybrid_rwkv7_s5_mla_trunk'


def rms_norm(x, g):
    xf = x.astype(jnp.float32)
    xf = xf * lax.rsqrt(jnp.mean(xf * xf, axis=-1, keepdims=True) + NORM_EPS)
    return xf * g.astype(jnp.float32)


def ada_modulation(c, w, b):
    m = (jax.nn.silu(c.astype(jnp.float32)) @ w + b)[:, None, :]
    return m[..., :D_MODEL], m[..., D_MODEL:2 * D_MODEL], m[..., 2 * D_MODEL:]


def token_shift(p, mu):
    prev = jnp.pad(p, ((0, 0), (1, 0), (0, 0)))[:, :-1]
    return p + (prev - p) * mu


def rwkv7_time_mix(p, mu, w0, w2, a0, a2, k_k, k_a, r_k, lnx_g, lnx_b):
    bsz, seq, _ = p.shape
    W, H, N, R = RWKV_WIDTH, RWKV_HEADS, RWKV_HEAD, RWKV_LORA
    p = token_shift(p.astype(jnp.float32), mu)
    r, k, v, g = p[..., :W], p[..., W:2 * W], p[..., 2 * W:3 * W], p[..., 3 * W:4 * W]
    w_lo, a_lo = p[..., 4 * W:4 * W + R], p[..., 4 * W + R:]
    w = -jax.nn.softplus(-(w0 + jnp.tanh(w_lo) @ w2)) - 0.5
    decay = jnp.exp(-jnp.exp(w))
    a = jax.nn.sigmoid(a0 + a_lo @ a2)
    heads = lambda t: t.reshape(bsz, seq, H, N)
    kk = heads(k * k_k)
    kk = kk * lax.rsqrt(jnp.maximum(jnp.sum(kk * kk, -1, keepdims=True), 1e-24))
    k = k * (1.0 + (a - 1.0) * k_a)
    r, k, v, decay, a = heads(r), heads(k), heads(v), heads(decay), heads(a)

    def step(state, inp):
        r_t, dec_t, k_t, v_t, rem_t, rep_t = inp
        sa = jnp.einsum('bhvk,bhk->bhv', state, rem_t)
        state = (state * dec_t[:, :, None, :] + sa[..., None] * rep_t[:, :, None, :]
                 + v_t[..., None] * k_t[:, :, None, :])
        return state, jnp.einsum('bhvk,bhk->bhv', state, r_t)

    tm = lambda t: jnp.swapaxes(t, 0, 1)
    xs = (tm(r), tm(decay), tm(k), tm(v), tm(-kk), tm(kk * a))
    s0 = jnp.zeros((bsz, H, N, N), jnp.float32)
    _, y = lax.scan(step, s0, xs)
    y = tm(y)
    mean = jnp.mean(y, -1, keepdims=True)
    var = jnp.mean(jnp.square(y - mean), -1, keepdims=True)
    y = ((y - mean) * lax.rsqrt(var + LNX_EPS)).reshape(bsz, seq, W) * lnx_g + lnx_b
    bonus = jnp.sum(r * k * r_k.reshape(H, N), -1, keepdims=True) * v
    y = y + bonus.reshape(bsz, seq, W)
    return y * jax.nn.silu(g)


def complex_linear_combine(left, right):
    a1r, a1i, b1r, b1i = left
    a2r, a2i, b2r, b2i = right
    return (a2r * a1r - a2i * a1i, a2r * a1i + a2i * a1r,
            a2r * b1r - a2i * b1i + b2r, a2r * b1i + a2i * b1r + b2i)


def s5_ssm(u, lam_re, lam_im, log_dt, b_re, b_im, c_re, c_im, d, glu_w, glu_b):
    bsz, seq, _ = u.shape
    G, P, N = S5_GROUPS, S5_GROUP, S5_STATE
    u = u.astype(jnp.float32)
    ug = u.reshape(bsz, seq, G, P)
    lam_re = lam_re.astype(jnp.float32)
    lam_im = lam_im.astype(jnp.float32)
    dt = jnp.exp(log_dt.astype(jnp.float32))[:, None]
    mag = jnp.exp(lam_re * dt)
    e_re, e_im = mag * jnp.cos(lam_im * dt), mag * jnp.sin(lam_im * dt)
    den = lam_re * lam_re + lam_im * lam_im
    coef_re = ((e_re - 1.0) * lam_re + e_im * lam_im) / den
    coef_im = (e_im * lam_re - (e_re - 1.0) * lam_im) / den
    bb_re = coef_re[..., None] * b_re - coef_im[..., None] * b_im
    bb_im = coef_re[..., None] * b_im + coef_im[..., None] * b_re
    bu_re = jnp.einsum('blgp,gnp->blgn', ug, bb_re)
    bu_im = jnp.einsum('blgp,gnp->blgn', ug, bb_im)
    a_re = jnp.broadcast_to(e_re, (1, seq, G, N))
    a_im = jnp.broadcast_to(e_im, (1, seq, G, N))
    _, _, x_re, x_im = lax.associative_scan(complex_linear_combine, (a_re, a_im, bu_re, bu_im), axis=1)
    y = jnp.einsum('gpn,blgn->blgp', c_re, x_re) - jnp.einsum('gpn,blgn->blgp', c_im, x_im)
    y = y.reshape(bsz, seq, S5_WIDTH) + d * u
    y = jax.nn.gelu(y)
    return y * jax.nn.sigmoid(y @ glu_w + glu_b)


def rope_tables(positions):
    inv_freq = 1.0 / (ROPE_BASE ** (jnp.arange(0, QK_ROPE, 2, dtype=jnp.float32) / QK_ROPE))
    ang = positions.astype(jnp.float32)[..., None] * inv_freq
    return jnp.cos(ang), jnp.sin(ang)


def apply_rope(t, cos, sin):
    half = t.shape[-1] // 2
    t1, t2 = t[..., :half], t[..., half:]
    return jnp.concatenate([t1 * cos - t2 * sin, t2 * cos + t1 * sin], axis=-1)


def mla_attention(p, cos, sin, q_norm, w_q_up, kv_norm, w_kv_up):
    bsz, seq, _ = p.shape
    H = MLA_HEADS
    p = p.astype(jnp.float32)
    o1, o2, o3 = Q_LORA, Q_LORA + KV_LORA, Q_LORA + KV_LORA + QK_ROPE
    c_q, c_kv, k_pe, g = p[..., :o1], p[..., o1:o2], p[..., o2:o3], p[..., o3:]
    q = (rms_norm(c_q, q_norm) @ w_q_up).reshape(bsz, seq, H, QK_NOPE + QK_ROPE)
    kv = (rms_norm(c_kv, kv_norm) @ w_kv_up).reshape(bsz, seq, H, QK_NOPE + V_HEAD)
    q_nope = q[..., :QK_NOPE]
    q_pe = apply_rope(q[..., QK_NOPE:], cos[:, :, None], sin[:, :, None])
    k_nope, v = kv[..., :QK_NOPE], kv[..., QK_NOPE:]
    k_pe = apply_rope(k_pe, cos, sin)
    n_blk = seq // Q_BLOCK
    blocks = lambda t: jnp.moveaxis(t.reshape(bsz, n_blk, Q_BLOCK, H, t.shape[-1]), 1, 0)
    k_idx = jnp.arange(seq)
    scale = 1.0 / math.sqrt(QK_NOPE + QK_ROPE)

    def attend(inp):
        qn, qp, blk = inp
        s = (jnp.einsum('bqhd,bkhd->bhqk', qn, k_nope)
             + jnp.einsum('bqhd,bkd->bhqk', qp, k_pe)).astype(jnp.float32)
        q_idx = blk * Q_BLOCK + jnp.arange(Q_BLOCK)
        causal = q_idx[:, None] >= k_idx[None, :]
        s = jnp.where(causal, s * scale, -1e30)
        probs = jax.nn.softmax(s, axis=-1)
        return jnp.einsum('bhqk,bkhd->bqhd', probs, v)

    o = lax.map(attend, (blocks(q_nope), blocks(q_pe), jnp.arange(n_blk)))
    o = jnp.moveaxis(o, 0, 1).reshape(bsz, seq, H * V_HEAD)
    return o * jax.nn.silu(g)


def setup_inputs(seed: int = 0) -> dict:
    key = jax.random.key(seed)
    keys = jax.random.split(key, 64)
    counter = [0]

    def nk():
        counter[0] += 1
        return keys[counter[0] - 1]

    def nrm(shape, scale):
        return scale * jax.random.normal(nk(), shape, jnp.float32)

    def gain(shape):
        return 1.0 + nrm(shape, 0.05)

    def unif(shape, lo, hi):
        return jax.random.uniform(nk(), shape, jnp.float32, lo, hi)

    D, NE, NO = D_MODEL, N_EVEN, N_ODD
    x = nrm((BATCH, SEQ, D), 1.0)
    c = nrm((BATCH, D), 1.0)
    positions = (jax.random.randint(nk(), (BATCH, 1), 0, 1024, jnp.int32)
                 + jnp.arange(SEQ, dtype=jnp.int32)[None, :])
    s5_n = jnp.pi * jnp.arange(S5_STATE, dtype=jnp.float32)
    return {
        'x': x, 'c': c, 'positions': positions,
        'ev_ada_w': nrm((NE, D, 3 * D), 0.5 * D ** -0.5),
        'ev_ada_b': nrm((NE, 3 * D), 0.01),
        'ev_norm_pre': gain((NE, D)),
        'ev_norm_post': gain((NE, D)),
        'ev_w_in': nrm((NE, D, EVEN_IN), D ** -0.5),
        'ev_mu': unif((NE, A_IN), 0.0, 1.0),
        'ev_w0': unif((NE, RWKV_WIDTH), -6.0, -1.0),
        'ev_w2': nrm((NE, RWKV_LORA, RWKV_WIDTH), 0.5 * RWKV_LORA ** -0.5),
        'ev_a0': nrm((NE, RWKV_WIDTH), 0.1),
        'ev_a2': nrm((NE, RWKV_LORA, RWKV_WIDTH), 0.5 * RWKV_LORA ** -0.5),
        'ev_k_k': 0.85 + nrm((NE, RWKV_WIDTH), 0.05),
        'ev_k_a': gain((NE, RWKV_WIDTH)),
        'ev_r_k': nrm((NE, RWKV_WIDTH), 0.1),
        'ev_lnx_g': gain((NE, RWKV_WIDTH)),
        'ev_lnx_b': nrm((NE, RWKV_WIDTH), 0.01),
        'ev_lam_re': -0.5 + nrm((NE, S5_GROUPS, S5_STATE), 0.01),
        'ev_lam_im': s5_n + nrm((NE, S5_GROUPS, S5_STATE), 0.01),
        'ev_log_dt': unif((NE, S5_GROUPS), math.log(1e-3), math.log(1e-1)),
        'ev_b_re': nrm((NE, S5_GROUPS, S5_STATE, S5_GROUP), (2.0 * S5_GROUP) ** -0.5),
        'ev_b_im': nrm((NE, S5_GROUPS, S5_STATE, S5_GROUP), (2.0 * S5_GROUP) ** -0.5),
        'ev_c_re': nrm((NE, S5_GROUPS, S5_GROUP, S5_STATE), (2.0 * S5_STATE) ** -0.5),
        'ev_c_im': nrm((NE, S5_GROUPS, S5_GROUP, S5_STATE), (2.0 * S5_STATE) ** -0.5),
        'ev_d': nrm((NE, S5_WIDTH), 1.0),
        'ev_glu_w': nrm((NE, S5_WIDTH, S5_WIDTH), S5_WIDTH ** -0.5),
        'ev_glu_b': nrm((NE, S5_WIDTH), 0.01),
        'ev_w_out': nrm((NE, EVEN_MIX, D), EVEN_MIX ** -0.5),
        'od_ada_w': nrm((NO, D, 3 * D), 0.5 * D ** -0.5),
        'od_ada_b': nrm((NO, 3 * D), 0.01),
        'od_norm_pre': gain((NO, D)),
        'od_norm_post': gain((NO, D)),
        'od_w_in': nrm((NO, D, ODD_IN), D ** -0.5),
        'od_q_norm': gain((NO, Q_LORA)),
        'od_w_q_up': nrm((NO, Q_LORA, MLA_HEADS * (QK_NOPE + QK_ROPE)), Q_LORA ** -0.5),
        'od_kv_norm': gain((NO, KV_LORA)),
        'od_w_kv_up': nrm((NO, KV_LORA, MLA_HEADS * (QK_NOPE + V_HEAD)), KV_LORA ** -0.5),
        'od_w_out': nrm((NO, MLA_WIDTH, D), MLA_WIDTH ** -0.5),
    }


def reference(x, c, positions, ev_ada_w, ev_ada_b, ev_norm_pre, ev_norm_post, ev_w_in, ev_mu,
              ev_w0, ev_w2, ev_a0, ev_a2, ev_k_k, ev_k_a, ev_r_k, ev_lnx_g, ev_lnx_b,
              ev_lam_re, ev_lam_im, ev_log_dt, ev_b_re, ev_b_im, ev_c_re, ev_c_im, ev_d,
              ev_glu_w, ev_glu_b, ev_w_out, od_ada_w, od_ada_b, od_norm_pre, od_norm_post,
              od_w_in, od_q_norm, od_w_q_up, od_kv_norm, od_w_kv_up, od_w_out):
    h = x.astype(jnp.float32)
    cos, sin = rope_tables(positions)
    for i in range(DEPTH):
        j = i // 2
        if i % 2 == 0:
            shift, scale, gate = ada_modulation(c, ev_ada_w[j], ev_ada_b[j])
            z = rms_norm(h, ev_norm_pre[j]) * (1.0 + scale) + shift
            p = z @ ev_w_in[j]
            y_a = rwkv7_time_mix(p[..., :A_IN], ev_mu[j], ev_w0[j], ev_w2[j], ev_a0[j], ev_a2[j],
                                 ev_k_k[j], ev_k_a[j], ev_r_k[j], ev_lnx_g[j], ev_lnx_b[j])
            y_b = s5_ssm(p[..., A_IN:A_IN + S5_WIDTH], ev_lam_re[j], ev_lam_im[j], ev_log_dt[j],
                         ev_b_re[j], ev_b_im[j], ev_c_re[j], ev_c_im[j], ev_d[j],
                         ev_glu_w[j], ev_glu_b[j])
            y_b = y_b * jax.nn.silu(p[..., A_IN + S5_WIDTH:].astype(jnp.float32))
            y = jnp.concatenate([y_a, y_b], axis=-1) @ ev_w_out[j]
            post = ev_norm_post[j]
        else:
            shift, scale, gate = ada_modulation(c, od_ada_w[j], od_ada_b[j])
            z = rms_norm(h, od_norm_pre[j]) * (1.0 + scale) + shift
            p = z @ od_w_in[j]
            y = mla_attention(p, cos, sin, od_q_norm[j], od_w_q_up[j], od_kv_norm[j],
                              od_w_kv_up[j]) @ od_w_out[j]
            post = od_norm_post[j]
        h = h + gate * rms_norm(y, post)
    return h.astype(x.dtype)
```

```cpp
#include <hip/hip_runtime.h>
#include <hip/hip_cooperative_groups.h>
#include <cstdio>
#include <cstdint>
#include <cstring>
namespace cg = cooperative_groups;

#define LAS __attribute__((address_space(3)))
typedef unsigned short bf16_t;
typedef short bf16x8 __attribute__((ext_vector_type(8)));
typedef float f32x4 __attribute__((ext_vector_type(4)));
typedef float f32x2 __attribute__((ext_vector_type(2)));
typedef unsigned u32x4 __attribute__((ext_vector_type(4)));
typedef unsigned u32x2 __attribute__((ext_vector_type(2)));

constexpr int T_TOK = 16384, DM = 2048, SEQ = 4096;
constexpr int PE_LD = 6400;
constexpr int PO_LD = 3328;
constexpr float NORM_EPS = 1e-6f, LNX_EPS = 64e-5f;
constexpr float QSCALE = 0.07216878364870322f * 1.4426950408889634f;

constexpr size_t SZ_WE = (size_t)6400 * 2048 * 2 + (size_t)1024 * 1024 * 2 + (size_t)2048 * 2048 * 2;
constexpr size_t SZ_WO = (size_t)3328 * 2048 * 2 + (size_t)3072 * 512 * 2 + 2 * (size_t)2048 * 512 * 2 + (size_t)2048 * 2048 * 2;
constexpr size_t OFF_WBF = 0;
constexpr size_t OFF_ZM = OFF_WBF + 2 * (SZ_WE + SZ_WO);
constexpr size_t OFF_P = OFF_ZM + (size_t)T_TOK * 2048 * 2;
constexpr size_t OFF_Q = OFF_P + (size_t)T_TOK * PO_LD * 2;
constexpr size_t OFF_KV = OFF_P + (size_t)T_TOK * PE_LD * 2;
constexpr size_t OFF_SMALL = OFF_KV + (size_t)T_TOK * 2048 * 4;
constexpr size_t OFF_MOD = OFF_SMALL;
constexpr size_t OFF_TAB = OFF_MOD + 4 * 4 * 6144 * 4;
constexpr size_t OFF_KPE = OFF_TAB + (size_t)T_TOK * 32 * 8;
constexpr size_t OFF_RSQ = OFF_KPE + (size_t)T_TOK * 64 * 2;
constexpr size_t OFF_RSKV = OFF_RSQ + (size_t)T_TOK * 4;
constexpr size_t OFF_BONUS = OFF_RSKV + (size_t)T_TOK * 4;
constexpr size_t OFF_BAR = OFF_BONUS + (size_t)T_TOK * 16 * 4;
constexpr size_t OFF_LA = OFF_BAR + 16384;
constexpr size_t WS_NEED = OFF_LA + (size_t)T_TOK * 128 * 2;
constexpr size_t WE_IN = 0, WE_GLU = (size_t)6400 * 2048 * 2, WE_OUT = WE_GLU + (size_t)1024 * 1024 * 2;
constexpr size_t WO_IN = 0, WO_Q = (size_t)3328 * 2048 * 2, WO_K = WO_Q + (size_t)3072 * 512 * 2, WO_V = WO_K + (size_t)2048 * 512 * 2, WO_OUT = WO_V + (size_t)2048 * 512 * 2;

constexpr int LDS_BYTES = 163840;

enum { I_X = 0, I_C, I_POS, I_EV_ADA_W, I_EV_ADA_B, I_EV_NPRE, I_EV_NPOST, I_EV_WIN, I_EV_MU, I_EV_W0, I_EV_W2, I_EV_A0, I_EV_A2,
       I_EV_KK, I_EV_KA, I_EV_RK, I_EV_LNG, I_EV_LNB, I_EV_LRE, I_EV_LIM, I_EV_LOGDT, I_EV_BRE, I_EV_BIM, I_EV_CRE, I_EV_CIM, I_EV_D,
       I_EV_GLUW, I_EV_GLUB, I_EV_WOUT, I_OD_ADA_W, I_OD_ADA_B, I_OD_NPRE, I_OD_NPOST, I_OD_WIN, I_OD_QN, I_OD_WQ, I_OD_KVN, I_OD_WKV, I_OD_WOUT, N_IN };

struct Params {
    const void* in[40];
    float* out;
    unsigned char* ws;
    int reps[16];
};
#define INF(i) ((const float*)P.in[i])

__device__ __forceinline__ float bf2f(bf16_t v) { return __uint_as_float(((unsigned)v) << 16); }
typedef __bf16 bf16v2_t __attribute__((ext_vector_type(2)));
__device__ __forceinline__ unsigned cvt_pk_bf16(float lo, float hi) { const f32x2 v = {lo, hi}; const bf16v2_t r = __builtin_convertvector(v, bf16v2_t); return __builtin_bit_cast(unsigned, r); }
__device__ __forceinline__ bf16_t f2bf(float f) { return (bf16_t)(cvt_pk_bf16(f, 0.f) & 0xffffu); }
__device__ __forceinline__ bf16x8 pack8(f32x4 a, f32x4 b) { u32x4 w = {cvt_pk_bf16(a[0], a[1]), cvt_pk_bf16(a[2], a[3]), cvt_pk_bf16(b[0], b[1]), cvt_pk_bf16(b[2], b[3])}; return *reinterpret_cast<bf16x8*>(&w); }
__device__ __forceinline__ void unpack8(u32x4 w, float* f) {
#pragma unroll
    for (int i = 0; i < 4; ++i) { f[2 * i] = __uint_as_float(w[i] << 16); f[2 * i + 1] = __uint_as_float(w[i] & 0xffff0000u); }
}
__device__ __forceinline__ float ex2(float x) { return __builtin_amdgcn_exp2f(x); }
__device__ __forceinline__ float fexp(float x) { return __builtin_amdgcn_exp2f(x * 1.4426950408889634f); }
__device__ __forceinline__ float flog(float x) { return __builtin_amdgcn_logf(x) * 0.6931471805599453f; }
__device__ __forceinline__ float fsigmoid(float x) { return __builtin_amdgcn_rcpf(1.0f + fexp(-x)); }
__device__ __forceinline__ float fsilu(float x) { return x * fsigmoid(x); }
__device__ __forceinline__ float ftanh(float x) { return 1.0f - 2.0f * __builtin_amdgcn_rcpf(1.0f + fexp(2.0f * x)); }
__device__ __forceinline__ float fsoftplus(float x) { return fmaxf(x, 0.f) + flog(1.0f + fexp(-fabsf(x))); }
__device__ __forceinline__ float fgelu(float x) { return 0.5f * x * (1.0f + ftanh(0.7978845608028654f * (x + 0.044715f * x * x * x))); }
template <int CTRL> __device__ __forceinline__ float dppf(float v) { return __int_as_float(__builtin_amdgcn_update_dpp(0, __float_as_int(v), CTRL, 0xF, 0xF, true)); }
__device__ __forceinline__ float row16_sum(float v) { v += dppf<0xB1>(v); v += dppf<0x4E>(v); v += dppf<0x124>(v); v += dppf<0x128>(v); return v; }
__device__ __forceinline__ float wave_sum(float v) { v = row16_sum(v); v += __shfl_xor(v, 16); v += __shfl_xor(v, 32); return v; }
__device__ __forceinline__ int launder_tid(int wv) { int t = wv * 64 + (int)__builtin_amdgcn_mbcnt_hi(~0u, __builtin_amdgcn_mbcnt_lo(~0u, 0u)); asm volatile("" : "+v"(t)); return t; }
__device__ __forceinline__ unsigned launder_u(unsigned v) { asm volatile("" : "+v"(v)); return v; }
#define WAVE_SYNC() do { asm volatile("s_waitcnt lgkmcnt(0)" ::: "memory"); __builtin_amdgcn_wave_barrier(); } while (0)
#define MFMA16(a, b, c) __builtin_amdgcn_mfma_f32_16x16x32_bf16(a, b, c, 0, 0, 0)

namespace pg8 {
constexpr int BM = 256, BK = 64, HALF = 128, HTB = HALF * BK * 2, STAGE_BYTES = 8 * HTB, NXCD = 8, WGM = 8;
__device__ __forceinline__ int lds_byte(int r, int c) { const int st = (r >> 4) * 2 + (c >> 5), rr = r & 15, cc = c & 31, ob = rr * 64 + cc * 2; return st * 1024 + (ob ^ (((ob >> 9) & 1) << 5)); }
__device__ __forceinline__ void stage_rc(int b, int& R, int& C) { const int st = b / 1024, sb = b % 1024, swz = sb ^ (((sb >> 9) & 1) << 5); R = (st >> 1) * 16 + swz / 64; C = (st & 1) * 32 + (swz % 64) / 2; }
__device__ __forceinline__ int perm32(int rho) { const int n = rho >> 4, i = rho & 15; return 8 * (i >> 2) + 4 * n + (i & 3); }
struct Unit { int pm, pn; };
struct Gemm { const bf16_t* A; const bf16_t* Bt; int M, N, K, lda, ldb; };
struct StaticOrder {
    int nM, nN, nwg, G, c;
    __device__ void init(int M, int N, int G_, int c_) { nM = M / BM; nN = N / BM; nwg = nM * nN; G = G_; c = c_; }
    __device__ bool next(int i, Unit& u) const {
        const long L = (long)i * G + c; if (L >= nwg) return false;
        int wgid = (int)L; { const int q = nwg / NXCD, r = nwg % NXCD, xcd = wgid % NXCD, off = wgid / NXCD; wgid = (xcd < r ? xcd * (q + 1) : r * (q + 1) + (xcd - r) * q) + off; }
        const int nig = WGM * nN, gid = wgid / nig, fm = gid * WGM, gsz = (nM - fm) < WGM ? (nM - fm) : WGM;
        u.pm = fm + ((wgid % nig) % gsz); u.pn = (wgid % nig) / gsz; return true;
    }
};

template <class Epi>
__device__ __forceinline__ void gemm_phase(const int wv, LAS unsigned char* lds, const Gemm g, const StaticOrder& S, const Epi& E) {
    const int tid = launder_tid(wv), wid = wv, lane = tid & 63, wr = wid >> 2, wc = wid & 3, fr = lane & 15, fq = lane >> 4;
    const int K = g.K, nt = K / BK;
    unsigned voffA[2], voffB[2];
#pragma unroll
    for (int i = 0; i < 2; ++i) { int R, C; stage_rc(tid * 16 + i * 8192, R, C); const int Rb = Epi::PERM ? ((R & ~31) + perm32(R & 31)) : R;
        voffA[i] = (unsigned)(R * g.lda + C) * 2u; voffB[i] = (unsigned)(Rb * g.ldb + C) * 2u; }
    const size_t kstep = (size_t)(BK * 2);
    const size_t hstepA = (size_t)HALF * g.lda * 2, hstepB = (size_t)HALF * g.ldb * 2;
    const size_t tstepA = 2 * hstepA, tstepB = 2 * hstepB;
    const unsigned ldsw = (unsigned)wid * 1024u;
    const int aoff = lds_byte(wr * 64 + fr, fq * 8), boff = lds_byte(wc * 32 + fr, fq * 8);
#define PG8_SA(b, h) (((b) * 2 + (h)) * HTB)
#define PG8_SB(b, h) ((4 + (b) * 2 + (h)) * HTB)
#define PG8_STAGE(bufoff, gbase, voff) do { _Pragma("unroll") for (int _i = 0; _i < 2; ++_i) \
        __builtin_amdgcn_global_load_lds((const unsigned*)((const char*)(gbase) + (voff)[_i]), (LAS unsigned*)(lds + (bufoff) + ldsw + _i * 8192), 16, 0, 0); } while (0)
#define PG8_LDA(dst, b, h) do { _Pragma("unroll") for (int m = 0; m < 4; ++m) _Pragma("unroll") for (int k = 0; k < 2; ++k) dst[m][k] = *(const LAS bf16x8*)(lds + PG8_SA(b, h) + aoff + m * 2048 + k * 1024); } while (0)
#define PG8_LDB(dst, b, h) do { _Pragma("unroll") for (int n = 0; n < 2; ++n) _Pragma("unroll") for (int k = 0; k < 2; ++k) dst[n][k] = *(const LAS bf16x8*)(lds + PG8_SB(b, h) + boff + n * 2048 + k * 1024); } while (0)
#define PG8_MMA(ai, bj, At, Bt) do { __builtin_amdgcn_s_setprio(1); _Pragma("unroll") for (int m = 0; m < 4; ++m) _Pragma("unroll") for (int n = 0; n < 2; ++n) _Pragma("unroll") for (int k = 0; k < 2; ++k) \
        acc[ai][bj][m][n] = __builtin_amdgcn_mfma_f32_16x16x32_bf16(Bt[n][k], At[m][k], acc[ai][bj][m][n], 0, 0, 0); __builtin_amdgcn_s_setprio(0); } while (0)
#define PG8_WAIT_V(n) asm volatile("s_waitcnt vmcnt(" #n ")" ::: "memory")
#define PG8_WAIT_L(n) asm volatile("s_waitcnt lgkmcnt(" #n ")" ::: "memory")
#define PG8_BAR __builtin_amdgcn_s_barrier()
#define PG8_SCHED __builtin_amdgcn_sched_barrier(0)
    Unit cur, nxt; int ui = 0;
    if (!S.next(0, cur)) return;
    f32x4 acc[2][2][4][2];
#pragma unroll
    for (int a = 0; a < 2; ++a)
#pragma unroll
        for (int b = 0; b < 2; ++b)
#pragma unroll
            for (int m = 0; m < 4; ++m)
#pragma unroll
                for (int n = 0; n < 2; ++n) acc[a][b][m][n] = (f32x4){0.f, 0.f, 0.f, 0.f};
    bf16x8 At[4][2], B0[2][2], B1[2][2];
    const char* cA = (const char*)g.A + (size_t)cur.pm * tstepA; const char* cB = (const char*)g.Bt + (size_t)cur.pn * tstepB;
    PG8_STAGE(PG8_SB(0, 0), cB, voffB); PG8_STAGE(PG8_SA(0, 0), cA, voffA); PG8_STAGE(PG8_SB(0, 1), cB + hstepB, voffB); PG8_STAGE(PG8_SA(0, 1), cA + hstepA, voffA);
    if (wr == 1) PG8_BAR;
    PG8_WAIT_V(4); PG8_BAR;
    PG8_STAGE(PG8_SB(1, 0), cB + kstep, voffB); PG8_STAGE(PG8_SA(1, 0), cA + kstep, voffA); PG8_STAGE(PG8_SB(1, 1), cB + hstepB + kstep, voffB);
    PG8_WAIT_V(6); PG8_BAR;
    for (;;) {
        const bool has_next = S.next(ui + 1, nxt);
        const char* nA = has_next ? (const char*)g.A + (size_t)nxt.pm * tstepA : cA; const char* nB = has_next ? (const char*)g.Bt + (size_t)nxt.pn * tstepB : cB;
        for (int t = 0; t < nt; t += 2) {
            const bool last = (t == nt - 2);
            const char* a1 = cA + (size_t)(t + 1) * kstep;
            const char* a2 = last ? nA : cA + (size_t)(t + 2) * kstep; const char* b2 = last ? nB : cB + (size_t)(t + 2) * kstep;
            const char* a3 = a2 + kstep; const char* b3 = b2 + kstep;
            PG8_LDB(B0, 0, 0); PG8_SCHED; PG8_LDA(At, 0, 0); PG8_STAGE(PG8_SA(1, 1), a1 + hstepA, voffA);
            PG8_WAIT_L(8); PG8_BAR; PG8_WAIT_L(0); PG8_MMA(0, 0, At, B0); PG8_BAR; PG8_SCHED;
            PG8_LDB(B1, 0, 1); PG8_STAGE(PG8_SB(0, 0), b2, voffB);
            PG8_BAR; PG8_WAIT_L(0); PG8_MMA(0, 1, At, B1); PG8_BAR;
            PG8_LDA(At, 0, 1); PG8_STAGE(PG8_SA(0, 0), a2, voffA);
            PG8_BAR; PG8_WAIT_L(0); PG8_MMA(1, 0, At, B0); PG8_BAR; PG8_SCHED;
            PG8_STAGE(PG8_SB(0, 1), b2 + hstepB, voffB);
            PG8_WAIT_V(6); PG8_BAR; PG8_MMA(1, 1, At, B1); PG8_BAR;
            PG8_LDB(B0, 1, 0); PG8_SCHED; PG8_LDA(At, 1, 0); PG8_STAGE(PG8_SA(0, 1), a2 + hstepA, voffA);
            PG8_WAIT_L(8); PG8_BAR; PG8_WAIT_L(0); PG8_MMA(0, 0, At, B0); PG8_BAR; PG8_SCHED;
            PG8_LDB(B1, 1, 1); PG8_STAGE(PG8_SB(1, 0), b3, voffB);
            PG8_BAR; PG8_WAIT_L(0); PG8_MMA(0, 1, At, B1); PG8_BAR;
            PG8_LDA(At, 1, 1); PG8_STAGE(PG8_SA(1, 0), a3, voffA);
            PG8_BAR; PG8_WAIT_L(0); PG8_MMA(1, 0, At, B0); PG8_BAR; PG8_SCHED;
            PG8_STAGE(PG8_SB(1, 1), b3 + hstepB, voffB);
            PG8_WAIT_V(6); PG8_BAR; PG8_MMA(1, 1, At, B1); PG8_BAR;
        }
        E(acc, cur, wr, wc, fr, fq);
        if (!has_next) break;
#pragma unroll
        for (int a = 0; a < 2; ++a)
#pragma unroll
            for (int b = 0; b < 2; ++b)
#pragma unroll
                for (int m = 0; m < 4; ++m)
#pragma unroll
                    for (int n = 0; n < 2; ++n) acc[a][b][m][n] = (f32x4){0.f, 0.f, 0.f, 0.f};
        cur = nxt; cA = nA; cB = nB; ++ui;
    }
    PG8_WAIT_V(0);
    if (wr == 0) PG8_BAR;
    PG8_BAR;
#undef PG8_SA
#undef PG8_SB
#undef PG8_STAGE
#undef PG8_LDA
#undef PG8_LDB
#undef PG8_MMA
#undef PG8_WAIT_V
#undef PG8_WAIT_L
#undef PG8_BAR
#undef PG8_SCHED
}
}

enum { EPI_BF16 = 0, EPI_F32 = 1, EPI_Q = 2, EPI_KN = 3, EPI_VT = 4, EPI_GLU = 5 };
template <int MODE> struct Epi {
    static constexpr bool PERM = (MODE != EPI_F32);
    void* O; int ldc;
    const float* rs;
    const float* tab;
    const float* bias;
    const bf16_t* yg;
    const bf16_t* pe;
    __device__ __forceinline__ void operator()(const f32x4 (&acc)[2][2][4][2], const pg8::Unit& u, int wr, int wc, int fr, int fq) const {
        const int row0 = u.pm * 256 + wr * 64 + fr;
        if constexpr (MODE == EPI_F32) {
            const int col0 = u.pn * 256 + wc * 32 + 4 * fq;
#pragma unroll
            for (int ai = 0; ai < 2; ++ai)
#pragma unroll
                for (int m = 0; m < 4; ++m) { float* rowp = (float*)O + (size_t)(row0 + ai * 128 + m * 16) * ldc + col0;
#pragma unroll
                    for (int bj = 0; bj < 2; ++bj)
#pragma unroll
                        for (int n = 0; n < 2; ++n) *(f32x4*)(rowp + bj * 128 + n * 16) = acc[ai][bj][m][n]; }
        } else {
            const int colb = u.pn * 256 + wc * 32 + 8 * fq;
#pragma unroll
            for (int ai = 0; ai < 2; ++ai)
#pragma unroll
                for (int m = 0; m < 4; ++m) {
                    const int row = row0 + ai * 128 + m * 16;
                    float rsc = 1.f;
                    if constexpr (MODE == EPI_Q) rsc = rs[row] * QSCALE;
                    if constexpr (MODE == EPI_KN) rsc = rs[row];
#pragma unroll
                    for (int bj = 0; bj < 2; ++bj) {
                        const int col = colb + bj * 128;
                        f32x4 v0 = acc[ai][bj][m][0], v1 = acc[ai][bj][m][1];
                        if constexpr (MODE == EPI_Q || MODE == EPI_KN) { v0 *= rsc; v1 *= rsc; }
                        if constexpr (MODE == EPI_Q) {
                            const int off = col % 192;
                            if (off >= 128) {
                                const int i0 = (off - 128) >> 1;
                                const f32x4 cs0 = *(const f32x4*)(tab + ((size_t)row * 32 + i0) * 2), cs1 = *(const f32x4*)(tab + ((size_t)row * 32 + i0 + 2) * 2);
                                f32x4 r0, r1;
                                r0[0] = v0[0] * cs0[0] - v0[1] * cs0[1]; r0[1] = v0[1] * cs0[0] + v0[0] * cs0[1];
                                r0[2] = v0[2] * cs0[2] - v0[3] * cs0[3]; r0[3] = v0[3] * cs0[2] + v0[2] * cs0[3];
                                r1[0] = v1[0] * cs1[0] - v1[1] * cs1[1]; r1[1] = v1[1] * cs1[0] + v1[0] * cs1[1];
                                r1[2] = v1[2] * cs1[2] - v1[3] * cs1[3]; r1[3] = v1[3] * cs1[2] + v1[2] * cs1[3];
                                v0 = r0; v1 = r1;
                            }
                        }
                        if constexpr (MODE == EPI_VT) {
                            const f32x4 s0 = *(const f32x4*)(rs + col), s1 = *(const f32x4*)(rs + col + 4);
                            v0 *= s0; v1 *= s1;
                        }
                        if constexpr (MODE == EPI_GLU) {
                            const f32x4 b0 = *(const f32x4*)(bias + col), b1 = *(const f32x4*)(bias + col + 4);
                            float yv[8], gv[8];
                            unpack8(*(const u32x4*)(yg + (size_t)row * 1024 + col), yv);
                            unpack8(*(const u32x4*)(pe + (size_t)row * PE_LD + 5120 + col), gv);
#pragma unroll
                            for (int e = 0; e < 4; ++e) { v0[e] = yv[e] * fsigmoid(v0[e] + b0[e]) * fsilu(gv[e]); v1[e] = yv[4 + e] * fsigmoid(v1[e] + b1[e]) * fsilu(gv[4 + e]); }
                            *(bf16x8*)((bf16_t*)O + (size_t)row * ldc + 1024 + col) = pack8(v0, v1);
                        } else {
                            *(bf16x8*)((bf16_t*)O + (size_t)row * ldc + col) = pack8(v0, v1);
                        }
                    }
                }
        }
    }
};

template <int MODE>
__device__ __forceinline__ void run_gemm(const int wv, LAS unsigned char* lds, const bf16_t* A, int lda, const bf16_t* Bt, int ldb, int M, int N, int K, const Epi<MODE>& E) {
    pg8::Gemm g; g.A = A; g.Bt = Bt; g.M = M; g.N = N; g.K = K; g.lda = lda; g.ldb = ldb;
    pg8::StaticOrder S; S.init(M, N, (int)gridDim.x, (int)blockIdx.x);
    pg8::gemm_phase<Epi<MODE>>(wv, lds, g, S, E);
}

__device__ __forceinline__ void convert_job(const int wv, const float* src, int srcLd, int K, bf16_t* dst, int nDstTiles, int type, const float* kscale, LAS float* tile) {
    const int tid = launder_tid(wv), kT = K >> 6, total = nDstTiles * kT;
    for (int tix = blockIdx.x; tix < total; tix += gridDim.x) {
        const int dt = tix / kT, k0 = (tix % kT) * 64, d0 = dt * 64;
        int sc; bool perm = false;
        if (type == 0) sc = d0;
        else if (type == 1) sc = d0 < 4096 ? d0 : (d0 < 6144 ? d0 + 128 : (d0 < 6272 ? d0 - 6144 + 4096 : -1));
        else if (type == 2) sc = d0 < 1024 ? d0 : (d0 < 3072 ? d0 + 64 : (d0 < 3136 ? 1024 + (d0 - 3072) : -1));
        else if (type == 3) { const int head = dt / 3, part = dt % 3; sc = head * 192 + part * 64; perm = (part == 2); }
        else if (type == 4) { const int head = dt >> 1, part = dt & 1; sc = head * 256 + part * 64; }
        else { const int head = dt >> 1, part = dt & 1; sc = head * 256 + 128 + part * 64; }
        __syncthreads();
        if (sc >= 0) {
            const int kr = tid >> 4, c4 = (tid & 15) * 4;
#pragma unroll
            for (int i = 0; i < 2; ++i) {
                const int k = kr + 32 * i;
                f32x4 v = *(const f32x4*)(src + (size_t)(k0 + k) * srcLd + sc + c4);
                if (kscale) v *= kscale[k0 + k];
                tile[k * 65 + c4] = v[0]; tile[k * 65 + c4 + 1] = v[1]; tile[k * 65 + c4 + 2] = v[2]; tile[k * 65 + c4 + 3] = v[3];
            }
        }
        __syncthreads();
        const int row = tid >> 3, kc = (tid & 7) * 8;
        f32x4 a = {0.f, 0.f, 0.f, 0.f}, b = {0.f, 0.f, 0.f, 0.f};
        if (sc >= 0) {
            const int scol = perm ? ((row >> 1) + 32 * (row & 1)) : row;
#pragma unroll
            for (int e = 0; e < 4; ++e) { a[e] = tile[(kc + e) * 65 + scol]; b[e] = tile[(kc + 4 + e) * 65 + scol]; }
        }
        *(bf16x8*)(dst + (size_t)(d0 + row) * K + k0 + kc) = pack8(a, b);
    }
}

__device__ __forceinline__ void phase_prep(const int wv, const Params& P, LAS unsigned char* lds) {
    LAS float* tile = (LAS float*)lds;
    bf16_t* wbf = (bf16_t*)(P.ws + OFF_WBF);
    for (int lp = 0; lp < 2; ++lp) {
        unsigned char* we = P.ws + OFF_WBF + (size_t)lp * (SZ_WE + SZ_WO);
        unsigned char* wo = we + SZ_WE;
        convert_job(wv, INF(I_EV_WIN) + (size_t)lp * 2048 * 6272, 6272, 2048, (bf16_t*)(we + WE_IN), 100, 1, nullptr, tile);
        convert_job(wv, INF(I_EV_GLUW) + (size_t)lp * 1024 * 1024, 1024, 1024, (bf16_t*)(we + WE_GLU), 16, 0, nullptr, tile);
        convert_job(wv, INF(I_EV_WOUT) + (size_t)lp * 2048 * 2048, 2048, 2048, (bf16_t*)(we + WE_OUT), 32, 0, nullptr, tile);
        convert_job(wv, INF(I_OD_WIN) + (size_t)lp * 2048 * 3136, 3136, 2048, (bf16_t*)(wo + WO_IN), 52, 2, nullptr, tile);
        convert_job(wv, INF(I_OD_WQ) + (size_t)lp * 512 * 3072, 3072, 512, (bf16_t*)(wo + WO_Q), 48, 3, INF(I_OD_QN) + lp * 512, tile);
        convert_job(wv, INF(I_OD_WKV) + (size_t)lp * 512 * 4096, 4096, 512, (bf16_t*)(wo + WO_K), 32, 4, INF(I_OD_KVN) + lp * 512, tile);
        convert_job(wv, INF(I_OD_WKV) + (size_t)lp * 512 * 4096, 4096, 512, (bf16_t*)(wo + WO_V), 32, 5, INF(I_OD_KVN) + lp * 512, tile);
        convert_job(wv, INF(I_OD_WOUT) + (size_t)lp * 2048 * 2048, 2048, 2048, (bf16_t*)(wo + WO_OUT), 32, 0, nullptr, tile);
    }
    (void)wbf;
    {
        __syncthreads();
        LAS float* sc = (LAS float*)lds;
        LAS float* red = sc + 8192;
        const int tid = launder_tid(wv);
        for (int i = tid; i < 8192; i += 512) sc[i] = fsilu(INF(I_C)[i]);
        __syncthreads();
        float* mod = (float*)(P.ws + OFF_MOD);
        const int col = tid & 63, kg = tid >> 6;
        for (int item = blockIdx.x; item < 4 * 96; item += gridDim.x) {
            const int l = item / 96, j0 = (item % 96) * 64;
            const float* W = ((l & 1) ? INF(I_OD_ADA_W) : INF(I_EV_ADA_W)) + (size_t)(l >> 1) * 2048 * 6144;
            const float* Bv = ((l & 1) ? INF(I_OD_ADA_B) : INF(I_EV_ADA_B)) + (size_t)(l >> 1) * 6144;
            float a0 = 0.f, a1 = 0.f, a2 = 0.f, a3 = 0.f;
#pragma unroll 8
            for (int kk = 0; kk < 256; ++kk) {
                const int k = kg * 256 + kk;
                const float w = W[(size_t)k * 6144 + j0 + col];
                a0 += sc[k] * w; a1 += sc[2048 + k] * w; a2 += sc[4096 + k] * w; a3 += sc[6144 + k] * w;
            }
            red[(kg * 4 + 0) * 64 + col] = a0; red[(kg * 4 + 1) * 64 + col] = a1; red[(kg * 4 + 2) * 64 + col] = a2; red[(kg * 4 + 3) * 64 + col] = a3;
            __syncthreads();
            if (tid < 256) {
                const int b = tid >> 6;
                float s = 0.f;
#pragma unroll
                for (int g = 0; g < 8; ++g) s += red[(g * 4 + b) * 64 + col];
                mod[((size_t)l * 4 + b) * 6144 + j0 + col] = s + Bv[j0 + col];
            }
            __syncthreads();
        }
    }
    {
        float* tab = (float*)(P.ws + OFF_TAB);
        const int* pos = (const int*)P.in[I_POS];
        for (int idx = blockIdx.x * 512 + launder_tid(wv); idx < T_TOK * 32; idx += gridDim.x * 512) {
            const int t = idx >> 5, i = idx & 31;
            const float arg = (float)(-(double)(2 * i) / 64.0 * 13.287712379549449);
            const float inv = ex2(arg);
            const float ang = (float)pos[t] * inv;
            const double rev = (double)ang * 0.15915494309189535;
            const float fr = (float)(rev - floor(rev));
            tab[(size_t)idx * 2] = __builtin_amdgcn_cosf(fr);
            tab[(size_t)idx * 2 + 1] = __builtin_amdgcn_sinf(fr);
        }
    }
}

__device__ __forceinline__ void phase_resnorm(const int wv, const Params& P, const float* hsrc, const bf16_t* y, const float* post, const float* modcur, const float* pre, const float* modnext, bf16_t* zdst, float* hdst) {
    const int tid_ = launder_tid(wv); const int wave = wv, lane = tid_ & 63;
    for (int tok = blockIdx.x * 8 + wave; tok < T_TOK; tok += gridDim.x * 8) {
        const int b = tok >> 12;
        f32x4 hv[8];
#pragma unroll
        for (int i = 0; i < 8; ++i) hv[i] = *(const f32x4*)(hsrc + (size_t)tok * 2048 + i * 256 + lane * 4);
        if (y) {
            f32x4 yv[8]; float ss = 0.f;
#pragma unroll
            for (int i = 0; i < 8; ++i) { const u32x2 yw = *(const u32x2*)(y + (size_t)tok * 2048 + i * 256 + lane * 4); yv[i] = (f32x4){__uint_as_float(yw[0] << 16), __uint_as_float(yw[0] & 0xffff0000u), __uint_as_float(yw[1] << 16), __uint_as_float(yw[1] & 0xffff0000u)}; ss += yv[i][0] * yv[i][0] + yv[i][1] * yv[i][1] + yv[i][2] * yv[i][2] + yv[i][3] * yv[i][3]; }
            ss = wave_sum(ss);
            const float rs = rsqrtf(ss * (1.0f / 2048.0f) + NORM_EPS);
#pragma unroll
            for (int i = 0; i < 8; ++i) {
                const int c = i * 256 + lane * 4;
                const f32x4 g = *(const f32x4*)(modcur + (size_t)b * 6144 + 4096 + c), po = *(const f32x4*)(post + c);
                hv[i] += g * (yv[i] * rs) * po;
                *(f32x4*)(hdst + (size_t)tok * 2048 + c) = hv[i];
            }
        }
        if (zdst) {
            float ss = 0.f;
#pragma unroll
            for (int i = 0; i < 8; ++i) ss += hv[i][0] * hv[i][0] + hv[i][1] * hv[i][1] + hv[i][2] * hv[i][2] + hv[i][3] * hv[i][3];
            ss = wave_sum(ss);
            const float rs = rsqrtf(ss * (1.0f / 2048.0f) + NORM_EPS);
#pragma unroll
            for (int i = 0; i < 8; ++i) {
                const int c = i * 256 + lane * 4;
                const f32x4 pr = *(const f32x4*)(pre + c), sh = *(const f32x4*)(modnext + (size_t)b * 6144 + c), sc = *(const f32x4*)(modnext + (size_t)b * 6144 + 2048 + c);
                const f32x4 z = hv[i] * rs * pr * (sc + 1.0f) + sh;
                u32x2 w = {cvt_pk_bf16(z[0], z[1]), cvt_pk_bf16(z[2], z[3])};
                *(u32x2*)(zdst + (size_t)tok * 2048 + c) = w;
            }
        }
    }
}

__device__ __forceinline__ void phase_da(const int wv, const Params& P, int le) {
    const int tid = launder_tid(wv), lane = tid & 63, c = lane & 15, gq = lane >> 4;
    const bf16_t* pE = (const bf16_t*)(P.ws + OFF_P);
    bf16_t* SG = (bf16_t*)(P.ws + OFF_ZM);
    bf16_t* AV = SG + (size_t)T_TOK * 1024;
    const float* mu = INF(I_EV_MU) + le * 4224 + 4096;
    const int gw = blockIdx.x * 8 + wv, nwav = gridDim.x * 8;
    const int h = gw & 15;
    bf16x8 Bw[4][2], Ba[4][2];
    float w0c[4], a0c[4];
    {
        const float* w2 = INF(I_EV_W2) + (size_t)le * 64 * 1024;
        const float* a2 = INF(I_EV_A2) + (size_t)le * 64 * 1024;
#pragma unroll
        for (int nb = 0; nb < 4; ++nb) {
            const int n = h * 64 + 16 * nb + c;
            w0c[nb] = INF(I_EV_W0)[le * 1024 + n]; a0c[nb] = INF(I_EV_A0)[le * 1024 + n];
#pragma unroll
            for (int ks = 0; ks < 2; ++ks) {
                f32x4 w0v, w1v, a0v, a1v;
#pragma unroll
                for (int i = 0; i < 4; ++i) {
                    const int k = 32 * ks + 8 * gq + i;
                    w0v[i] = w2[(size_t)k * 1024 + n]; w1v[i] = w2[(size_t)(k + 4) * 1024 + n];
                    a0v[i] = a2[(size_t)k * 1024 + n]; a1v[i] = a2[(size_t)(k + 4) * 1024 + n];
                }
                Bw[nb][ks] = pack8(w0v, w1v); Ba[nb][ks] = pack8(a0v, a1v);
            }
        }
    }
    f32x4 mul[2][2][2];
#pragma unroll
    for (int which = 0; which < 2; ++which)
#pragma unroll
        for (int ks = 0; ks < 2; ++ks) { mul[which][ks][0] = *(const f32x4*)(mu + 64 * which + 32 * ks + 8 * gq); mul[which][ks][1] = *(const f32x4*)(mu + 64 * which + 32 * ks + 8 * gq + 4); }
    for (int tb = gw >> 4; tb < T_TOK / 16; tb += (nwav >> 4)) {
        const int tok = tb * 16 + c;
        const bool hasprev = (tok & (SEQ - 1)) != 0;
        bf16x8 Aw[2], Aa[2];
#pragma unroll
        for (int which = 0; which < 2; ++which)
#pragma unroll
            for (int ks = 0; ks < 2; ++ks) {
                const int col = 6144 + 64 * which + 32 * ks + 8 * gq;
                float cu[8], pv[8];
                unpack8(*(const u32x4*)(pE + (size_t)tok * PE_LD + col), cu);
                const u32x4 pw = *(const u32x4*)(pE + (size_t)(tok > 0 ? tok - 1 : 0) * PE_LD + col);
                unpack8(hasprev ? pw : (u32x4){0u, 0u, 0u, 0u}, pv);
                f32x4 x0, x1;
#pragma unroll
                for (int i = 0; i < 4; ++i) { x0[i] = cu[i] + (pv[i] - cu[i]) * mul[which][ks][0][i]; x1[i] = cu[4 + i] + (pv[4 + i] - cu[4 + i]) * mul[which][ks][1][i]; }
                if (which == 0) {
#pragma unroll
                    for (int i = 0; i < 4; ++i) { x0[i] = ftanh(x0[i]); x1[i] = ftanh(x1[i]); }
                    Aw[ks] = pack8(x0, x1);
                } else Aa[ks] = pack8(x0, x1);
            }
#pragma unroll
        for (int nb = 0; nb < 4; ++nb) {
            f32x4 wacc = {0.f, 0.f, 0.f, 0.f}, aacc = {0.f, 0.f, 0.f, 0.f};
            wacc = MFMA16(Aw[0], Bw[nb][0], wacc); wacc = MFMA16(Aw[1], Bw[nb][1], wacc);
            aacc = MFMA16(Aa[0], Ba[nb][0], aacc); aacc = MFMA16(Aa[1], Ba[nb][1], aacc);
            const size_t o_ = ((((size_t)tb * 16 + h) * 4 + nb) * 64 + lane) * 4;
            u32x2 sw = {cvt_pk_bf16(fsigmoid(w0c[nb] + wacc[0]), fsigmoid(w0c[nb] + wacc[1])), cvt_pk_bf16(fsigmoid(w0c[nb] + wacc[2]), fsigmoid(w0c[nb] + wacc[3]))};
            u32x2 aw = {cvt_pk_bf16(fsigmoid(a0c[nb] + aacc[0]), fsigmoid(a0c[nb] + aacc[1])), cvt_pk_bf16(fsigmoid(a0c[nb] + aacc[2]), fsigmoid(a0c[nb] + aacc[3]))};
            *(u32x2*)(SG + o_) = sw; *(u32x2*)(AV + o_) = aw;
        }
    }
}

__device__ __forceinline__ void phase_scan(const int wv, const Params& P, int le, LAS unsigned char* lds) {
    const int wave = wv;
    constexpr unsigned L_BUF = 0, BUF_SZ = 40960, A_SZ = 8192;
    constexpr unsigned L_VV = 81920, VV_SZ = 2048;
    constexpr unsigned L_YB = 86016;
    constexpr unsigned L_BU = 88064, BU_SZ = 8448;
    constexpr unsigned L_XS = 104960, XS_SZ = 4352;
    constexpr unsigned L_ENDS = 113664;
    constexpr unsigned L_COEF = 115712;
    constexpr unsigned L_LORA = 116224;
    constexpr unsigned L_CT = 132608;
    const bf16_t* pE = (const bf16_t*)(P.ws + OFF_P);
    bf16_t* ygelu = (bf16_t*)(P.ws + OFF_KV);
    float* yraw = (float*)(P.ws + OFF_KV + (size_t)T_TOK * 1024 * 2);
    float* bonus = (float*)(P.ws + OFF_BONUS);
    const float* mu = INF(I_EV_MU) + le * 4224;
    constexpr int NCH = 128;

    for (int item = blockIdx.x; item < 256; item += gridDim.x) {
        const int ritem = ((((item & 7) * 8) + ((item >> 3) >> 2)) << 2) | ((item >> 3) & 3);
        const int b = ritem >> 6, h = (ritem >> 2) & 15, vq = ritem & 3, g5 = ritem & 63;
        __syncthreads();
        if (wave < 4) {
            const int tid = launder_tid(wv), lane = tid & 63, c = lane & 15, gq = lane >> 4;
            if (wave == 1) {
                LAS float* CT = (LAS float*)(lds + L_CT);
                const int chn = h * 64 + lane;
                CT[lane] = INF(I_EV_W0)[le * 1024 + chn]; CT[64 + lane] = INF(I_EV_A0)[le * 1024 + chn]; CT[128 + lane] = INF(I_EV_KK)[le * 1024 + chn];
                CT[192 + lane] = INF(I_EV_KA)[le * 1024 + chn]; CT[256 + lane] = INF(I_EV_RK)[le * 1024 + chn]; CT[320 + lane] = mu[chn]; CT[384 + lane] = mu[1024 + chn];
                CT[448 + lane] = mu[4096 + lane]; CT[512 + lane] = mu[4096 + 64 + lane];
                if (lane < 16) CT[576 + lane] = mu[2048 + h * 64 + 16 * vq + lane];
            }
            __syncthreads();
            f32x2 Sa = {0.f, 0.f}, Sb = {0.f, 0.f};
            const int w = wave, lv = 4 * w + gq, ks = c;
            for (int it = 0; it <= NCH; ++it) {
                if (it >= 1) {
                    const int ch = it - 1, buf = ch & 1;
                    const LAS float* pB = (const LAS float*)(lds + launder_u(L_BUF + buf * BUF_SZ + 16 * ks));
                    const LAS float* pV = (const LAS float*)(lds + launder_u(L_VV + buf * VV_SZ + 4 * lv));
                    LAS float* pY = (LAS float*)(lds + launder_u((w < 2 ? 116224u + (unsigned)w * 8192u : 135168u + (unsigned)(w - 2) * 8192u) + (unsigned)lane * 4u));
#define SC_LOAD(X, t_) do { X##r = *(const LAS f32x4*)(pB + (t_) * 64); X##kq = *(const LAS f32x4*)(pB + 2048 + (t_) * 64); X##dec = *(const LAS f32x4*)(pB + 4096 + (t_) * 64); \
                        X##rem = *(const LAS f32x4*)(pB + 6144 + (t_) * 64); X##rep = *(const LAS f32x4*)(pB + 8192 + (t_) * 64); X##v = pV[(t_) * 16]; } while (0)
#define SC_STEP(X, t_) do { \
                        f32x2 p_ = Sa * (f32x2){X##rem[0], X##rem[1]}; p_ = __builtin_elementwise_fma(Sb, (f32x2){X##rem[2], X##rem[3]}, p_); \
                        const float sa_ = row16_sum(p_[0] + p_[1]); \
                        f32x2 ta_ = (f32x2){X##kq[0], X##kq[1]} * X##v; ta_ = __builtin_elementwise_fma(Sa, (f32x2){X##dec[0], X##dec[1]}, ta_); \
                        f32x2 tb_ = (f32x2){X##kq[2], X##kq[3]} * X##v; tb_ = __builtin_elementwise_fma(Sb, (f32x2){X##dec[2], X##dec[3]}, tb_); \
                        Sa = __builtin_elementwise_fma((f32x2){X##rep[0], X##rep[1]}, (f32x2){sa_, sa_}, ta_); Sb = __builtin_elementwise_fma((f32x2){X##rep[2], X##rep[3]}, (f32x2){sa_, sa_}, tb_); \
                        f32x2 q_ = Sa * (f32x2){X##r[0], X##r[1]}; q_ = __builtin_elementwise_fma(Sb, (f32x2){X##r[2], X##r[3]}, q_); \
                        const float yp_ = q_[0] + q_[1]; \
                        if ((t_) + 2 < 32) SC_LOAD(X, (t_) + 2); \
                        pY[(t_) * 64] = yp_; } while (0)
#ifdef PROBE_SCAN2
                    const f32x2 Sa_save = Sa, Sb_save = Sb;
#pragma unroll 1
                    for (int rep_ = 0; rep_ < PROBE_SCAN2; ++rep_) {
                    Sa = Sa_save; Sb = Sb_save;
#else
                    {
#endif
                    f32x4 Ar, Akq, Adec, Arem, Arep, Br, Bkq, Bdec, Brem, Brep; float Av, Bv;
                    SC_LOAD(A, 0); SC_LOAD(B, 1);
#pragma unroll
                    for (int t = 0; t < 32; t += 2) { SC_STEP(A, t); SC_STEP(B, t + 1); }
                    }
#undef SC_LOAD
#undef SC_STEP
                    WAVE_SYNC();
                    {
                        const LAS float* yb = (const LAS float*)(lds + launder_u((w < 2 ? 116224u + (unsigned)w * 8192u : 135168u + (unsigned)(w - 2) * 8192u) + (unsigned)((lane >> 2) * 256 + (lane & 3) * 64)));
#pragma unroll
                        for (int hh = 0; hh < 2; ++hh) {
                            const f32x4 a0 = *(const LAS f32x4*)(yb + hh * 1024), a1 = *(const LAS f32x4*)(yb + hh * 1024 + 4), a2 = *(const LAS f32x4*)(yb + hh * 1024 + 8), a3 = *(const LAS f32x4*)(yb + hh * 1024 + 12);
                            const f32x4 sm = (a0 + a1) + (a2 + a3);
                            const float yv = (sm[0] + sm[1]) + (sm[2] + sm[3]);
                            yraw[(size_t)(b * SEQ + ch * 32 + (lane >> 2) + 16 * hh) * 1024 + h * 64 + 16 * vq + 4 * w + (lane & 3)] = yv;
                        }
                    }
                    WAVE_SYNC();
                }
                __syncthreads();
            }
        } else if (wave < 6) {
            __syncthreads();
            const int tid = launder_tid(wv), lane = tid & 63, c = lane & 15, gq = lane >> 4;
            const int m = wave - 4;
            const unsigned voff_rk = (unsigned)((4 * gq * PE_LD + c) * 2);
            const bf16_t* SGp = (const bf16_t*)(P.ws + OFF_ZM) + (size_t)h * 1024 + lane * 4;
            const bf16_t* AVp = SGp + (size_t)T_TOK * 1024;
            u32x2 sgraw[4], avraw[4];
            unsigned short rraw[4][5], kraw[4][5], vraw[5];
#define PL_TOKBASE(pc_) (b * SEQ + ((pc_) < NCH - 1 ? (pc_) : NCH - 1) * 32 + 16 * m)
#define PREP_LOAD_DA(pc_, nb) do { const size_t to_ = (size_t)(PL_TOKBASE(pc_) >> 4) * 16384 + (nb) * 256; \
            sgraw[nb] = *(const u32x2*)(SGp + to_); avraw[nb] = *(const u32x2*)(AVp + to_); } while (0)
#define PREP_LOAD_RK(pc_, nb) do { const int tokbase_ = PL_TOKBASE(pc_); const int lseq0_ = (tokbase_ - b * SEQ) + 4 * gq; \
            _Pragma("unroll") for (int jj = 0; jj < 5; ++jj) { const bool valid = (jj > 0) || (lseq0_ > 0); \
                const char* ub_ = (const char*)(pE + (size_t)(tokbase_ + jj - 1) * PE_LD + h * 64); \
                const unsigned short r_ = *(const unsigned short*)(ub_ + voff_rk + 32 * (nb)), k_ = *(const unsigned short*)(ub_ + voff_rk + 2048 + 32 * (nb)); \
                rraw[nb][jj] = valid ? r_ : (unsigned short)0; kraw[nb][jj] = valid ? k_ : (unsigned short)0; } } while (0)
#define PREP_LOAD_V(pc_) do { const int tokbase_ = PL_TOKBASE(pc_); const int lseq0_ = (tokbase_ - b * SEQ) + 4 * gq; \
            _Pragma("unroll") for (int jj = 0; jj < 5; ++jj) { const bool valid = (jj > 0) || (lseq0_ > 0); \
                const char* ubv_ = (const char*)(pE + (size_t)(tokbase_ + jj - 1) * PE_LD + h * 64 + 2048 + 16 * vq); \
                const unsigned short v_ = *(const unsigned short*)(ubv_ + voff_rk); vraw[jj] = valid ? v_ : (unsigned short)0; } } while (0)
            PREP_LOAD_DA(0, 0); PREP_LOAD_DA(0, 1); PREP_LOAD_DA(0, 2); PREP_LOAD_DA(0, 3); PREP_LOAD_RK(0, 0); PREP_LOAD_RK(0, 1); PREP_LOAD_RK(0, 2); PREP_LOAD_RK(0, 3); PREP_LOAD_V(0);
            for (int it = 0; it <= NCH; ++it) {
                if (it < NCH) {
                    const int ch = it, buf = ch & 1;
                    const int tok4 = b * SEQ + ch * 32 + 16 * m + 4 * gq;
                    LAS float* wb = (LAS float*)(lds + launder_u(L_BUF + buf * BUF_SZ + ((16 * m + 4 * gq) * 64 + c) * 4));
                    LAS float* wbV = (LAS float*)(lds + launder_u(L_VV + buf * VV_SZ + ((16 * m + 4 * gq) * 16 + c) * 4));
                    const LAS float* ct = (const LAS float*)(lds + launder_u(L_CT + c * 4));
#ifdef PROBE_PREP2
#pragma unroll 1
                    for (int rep_ = 0; rep_ < PROBE_PREP2; ++rep_) {
                    const bool lastrep_ = (rep_ == PROBE_PREP2 - 1);
#else
                    {
                    const bool lastrep_ = true;
#endif
                    float ssq[4] = {0.f, 0.f, 0.f, 0.f}, bon[4] = {0.f, 0.f, 0.f, 0.f};
                    float kkv[4][4], avv[4][4];
#pragma unroll
                    for (int nb = 0; nb < 4; ++nb) {
                        const float kkc = ct[128 + 16 * nb], kac = ct[192 + 16 * nb], rkc = ct[256 + 16 * nb], mur = ct[320 + 16 * nb], muk = ct[384 + 16 * nb];
                        float rp[4], kp[4];
#pragma unroll
                        for (int j = 0; j < 4; ++j) {
                            const float r0 = bf2f(rraw[nb][j]), r1 = bf2f(rraw[nb][j + 1]), k0 = bf2f(kraw[nb][j]), k1 = bf2f(kraw[nb][j + 1]);
                            rp[j] = r1 + (r0 - r1) * mur; kp[j] = k1 + (k0 - k1) * muk;
                        }
                        if (lastrep_) PREP_LOAD_RK(ch + 1, nb);
                        float sgf[4], avf[4];
#pragma unroll
                        for (int j = 0; j < 4; ++j) { const unsigned sw_ = sgraw[nb][j >> 1], aw_ = avraw[nb][j >> 1]; sgf[j] = (j & 1) ? __uint_as_float(sw_ & 0xffff0000u) : __uint_as_float(sw_ << 16); avf[j] = (j & 1) ? __uint_as_float(aw_ & 0xffff0000u) : __uint_as_float(aw_ << 16); }
                        if (lastrep_) PREP_LOAD_DA(ch + 1, nb);
#pragma unroll
                        for (int j = 0; j < 4; ++j) {
                            const float dec = ex2(sgf[j] * (-0.6065306597126334f * 1.4426950408889634f));
                            const float av = avf[j];
                            const float kk = kp[j] * kkc, k2 = kp[j] * (1.0f + (av - 1.0f) * kac);
                            ssq[j] += kk * kk; bon[j] += rp[j] * k2 * rkc;
                            const int lo = j * 64 + 16 * nb;
                            wb[lo] = rp[j]; wb[2048 + lo] = k2; wb[4096 + lo] = dec; kkv[nb][j] = kk; avv[nb][j] = av;
                        }
                        __builtin_amdgcn_sched_barrier(0);
                    }
#pragma unroll
                    for (int j = 0; j < 4; ++j) {
                        const float tot = row16_sum(ssq[j]);
                        const float inv = rsqrtf(fmaxf(tot, 1e-24f));
                        const float bt = row16_sum(bon[j]);
                        if (vq == 0 && c == 0) bonus[(size_t)(tok4 + j) * 16 + h] = bt;
#pragma unroll
                        for (int nb = 0; nb < 4; ++nb) {
                            const int lo = j * 64 + 16 * nb;
                            const float kn = kkv[nb][j] * inv;
                            wb[6144 + lo] = -kn; wb[8192 + lo] = kn * avv[nb][j];
                        }
                    }
                    const float muv = ct[576];
#pragma unroll
                    for (int j = 0; j < 4; ++j) { const float v0 = bf2f(vraw[j]), v1 = bf2f(vraw[j + 1]); wbV[j * 16] = v1 + (v0 - v1) * muv; }
                    if (lastrep_) PREP_LOAD_V(ch + 1);
                    }
                }
                __syncthreads();
            }
#undef PREP_LOAD_DA
#undef PREP_LOAD_RK
#undef PREP_LOAD_V
#undef PL_TOKBASE
        } else {
            const int ws = wave - 6;
            bf16x8 Bbb[8], Bc[4];
            float e_re = 0.f, e_im = 0.f, E16r = 0.f, E16i = 0.f, X0r = 0.f, X0i = 0.f, dval = 0.f;
            {
                const int tid = launder_tid(wv), lane = tid & 63, c = lane & 15, n = lane;
                const float dt = fexp(INF(I_EV_LOGDT)[le * 64 + g5]);
                const float lr = INF(I_EV_LRE)[(le * 64 + g5) * 64 + n], li = INF(I_EV_LIM)[(le * 64 + g5) * 64 + n];
                const float mag = fexp(lr * dt), ang = li * dt;
                const double rev = (double)ang * 0.15915494309189535;
                const float fr = (float)(rev - floor(rev));
                e_re = mag * __builtin_amdgcn_cosf(fr); e_im = mag * __builtin_amdgcn_sinf(fr);
                const float den = lr * lr + li * li;
                const float cr = ((e_re - 1.0f) * lr + e_im * li) / den, ci = (e_im * lr - (e_re - 1.0f) * li) / den;
                if (ws == 0) { LAS float* COEF = (LAS float*)(lds + L_COEF); COEF[n] = cr; COEF[64 + n] = ci; }
                float pr = e_re, pi = e_im;
#pragma unroll
                for (int s = 0; s < 4; ++s) { const float nr = pr * pr - pi * pi, ni = 2.0f * pr * pi; pr = nr; pi = ni; }
                E16r = pr; E16i = pi;
                dval = INF(I_EV_D)[le * 1024 + g5 * 16 + c];
            }
            __syncthreads();
            {
                const int tid2 = launder_tid(wv), c = tid2 & 15, gq = (tid2 >> 4) & 3;
                const LAS float* COEF = (const LAS float*)(lds + L_COEF);
                const float* bre = INF(I_EV_BRE) + (size_t)(le * 64 + g5) * 64 * 16;
                const float* bim = INF(I_EV_BIM) + (size_t)(le * 64 + g5) * 64 * 16;
#pragma unroll
                for (int nb = 0; nb < 8; ++nb) {
                    const int n = 16 * (nb & 3) + c;
                    const float cr = COEF[n], ci = COEF[64 + n];
                    f32x4 v0 = {0.f, 0.f, 0.f, 0.f}, v1 = {0.f, 0.f, 0.f, 0.f};
                    if (gq < 2) {
                        const f32x4 r0 = *(const f32x4*)(bre + n * 16 + 8 * gq), r1 = *(const f32x4*)(bre + n * 16 + 8 * gq + 4);
                        const f32x4 i0 = *(const f32x4*)(bim + n * 16 + 8 * gq), i1 = *(const f32x4*)(bim + n * 16 + 8 * gq + 4);
                        if (nb < 4) { v0 = r0 * cr - i0 * ci; v1 = r1 * cr - i1 * ci; } else { v0 = i0 * cr + r0 * ci; v1 = i1 * cr + r1 * ci; }
                    }
                    Bbb[nb] = pack8(v0, v1);
                    __builtin_amdgcn_sched_barrier(0);
                }
                const float* cre = INF(I_EV_CRE) + (size_t)((le * 64 + g5) * 16 + c) * 64;
                const float* cim = INF(I_EV_CIM) + (size_t)((le * 64 + g5) * 16 + c) * 64;
#pragma unroll
                for (int ks = 0; ks < 4; ++ks) {
                    const int nn = 32 * ks + 8 * gq;
                    f32x4 v0, v1;
                    if (ks < 2) { v0 = *(const f32x4*)(cre + nn); v1 = *(const f32x4*)(cre + nn + 4); }
                    else { v0 = -*(const f32x4*)(cim + nn - 64); v1 = -*(const f32x4*)(cim + nn - 64 + 4); }
                    Bc[ks] = pack8(v0, v1);
                    __builtin_amdgcn_sched_barrier(0);
                }
            }
            {
                const int tid3 = launder_tid(wv), lane = tid3 & 63, c = lane & 15, gq = lane >> 4, n = lane;
                LAS float* bu = (LAS float*)(lds + launder_u(L_BU + ws * BU_SZ + n * 4));
                LAS float* buw = (LAS float*)(lds + launder_u(L_BU + ws * BU_SZ + ((4 * gq) * 132 + c) * 4));
                LAS bf16_t* xsw = (LAS bf16_t*)(lds + launder_u(L_XS + ws * XS_SZ + n * 2));
                const LAS bf16_t* xs = (const LAS bf16_t*)(lds + launder_u(L_XS + ws * XS_SZ + (c * 136 + 8 * gq) * 2));
                LAS float* ends = (LAS float*)(lds + launder_u(L_ENDS + n * 4));
                bf16x8 Acur = {0, 0, 0, 0, 0, 0, 0, 0};
                if (gq < 2) Acur = *(const bf16x8*)(pE + (size_t)(b * SEQ + 16 * ws + c) * PE_LD + 4096 + g5 * 16 + 8 * gq);
                unsigned short ucur[4], uprev[4] = {0, 0, 0, 0};
#pragma unroll
                for (int j = 0; j < 4; ++j) ucur[j] = pE[(size_t)(b * SEQ + 16 * ws + 4 * gq + j) * PE_LD + 4096 + g5 * 16 + c];
                for (int it = 0; it <= NCH; ++it) {
                    if (it >= 1) {
                        const int ch = it - 1, par = ch & 1;
                        const int tok0 = b * SEQ + ch * 32 + 16 * ws;
                        float cr = X0r, ci = X0i, cinr = 0.f, cini = 0.f;
#pragma unroll
                        for (int s = 0; s < 2; ++s) {
                            if (s == ws) { cinr = cr; cini = ci; }
                            const float er = ends[(par * 2 + s) * 128], ei = ends[(par * 2 + s) * 128 + 64];
                            const float nr = E16r * cr - E16i * ci + er, ni = E16r * ci + E16i * cr + ei;
                            cr = nr; ci = ni;
                        }
                        X0r = cr; X0i = ci;
                        float xr = cinr, xi = cini;
#pragma unroll
                        for (int i = 0; i < 16; ++i) {
                            const float br = bu[i * 132], bi = bu[i * 132 + 64];
                            const float nr = e_re * xr - e_im * xi + br, ni = e_re * xi + e_im * xr + bi;
                            xr = nr; xi = ni;
                            xsw[i * 136] = f2bf(xr); xsw[i * 136 + 64] = f2bf(xi);
                        }
                        WAVE_SYNC();
                        f32x4 acc = {0.f, 0.f, 0.f, 0.f};
#pragma unroll
                        for (int ks = 0; ks < 4; ++ks) {
                            const bf16x8 A = *(const LAS bf16x8*)(xs + 32 * ks);
                            acc = MFMA16(A, Bc[ks], acc);
                        }
#pragma unroll
                        for (int j = 0; j < 4; ++j) {
                            const size_t tok = (size_t)(tok0 + 4 * gq + j);
                            ygelu[tok * 1024 + g5 * 16 + c] = f2bf(fgelu(acc[j] + dval * bf2f(uprev[j])));
                        }
                        WAVE_SYNC();
                    }
                    if (it < NCH) {
                        const int ch = it, par = ch & 1;
#pragma unroll
                        for (int nb = 0; nb < 8; ++nb) {
                            f32x4 acc = {0.f, 0.f, 0.f, 0.f};
                            acc = MFMA16(Acur, Bbb[nb], acc);
#pragma unroll
                            for (int j = 0; j < 4; ++j) buw[j * 132 + 16 * nb] = acc[j];
                        }
#pragma unroll
                        for (int j = 0; j < 4; ++j) uprev[j] = ucur[j];
                        {
                            const int nc = it + 1 < NCH ? it + 1 : NCH - 1;
                            const int tokn = b * SEQ + nc * 32 + 16 * ws;
                            if (gq < 2) Acur = *(const bf16x8*)(pE + (size_t)(tokn + c) * PE_LD + 4096 + g5 * 16 + 8 * gq);
#pragma unroll
                            for (int j = 0; j < 4; ++j) ucur[j] = pE[(size_t)(tokn + 4 * gq + j) * PE_LD + 4096 + g5 * 16 + c];
                        }
                        WAVE_SYNC();
                        float xr = 0.f, xi = 0.f;
#pragma unroll
                        for (int i = 0; i < 16; ++i) {
                            const float br = bu[i * 132], bi = bu[i * 132 + 64];
                            const float nr = e_re * xr - e_im * xi + br, ni = e_re * xi + e_im * xr + bi;
                            xr = nr; xi = ni;
                        }
                        ends[(par * 2 + ws) * 128] = xr; ends[(par * 2 + ws) * 128 + 64] = xi;
                    }
                    __syncthreads();
                }
            }
        }
    }
}

__device__ __forceinline__ void phase_rwkv_post(const int wv, const Params& P, int le) {
    const int tid_ = launder_tid(wv); const int wave = wv, lane = tid_ & 63;
    const bf16_t* pE = (const bf16_t*)(P.ws + OFF_P);
    const float* yraw = (const float*)(P.ws + OFF_KV + (size_t)T_TOK * 1024 * 2);
    const float* bonus = (const float*)(P.ws + OFF_BONUS);
    bf16_t* mix = (bf16_t*)(P.ws + OFF_ZM);
    const float* mu = INF(I_EV_MU) + le * 4224;
    const int hh = lane >> 4, cs = lane & 15;
#pragma unroll 2
    for (int idx = blockIdx.x * 8 + wave; idx < T_TOK * 4; idx += gridDim.x * 8) {
        const int tok = idx >> 2, h = (idx & 3) * 4 + hh, chn = h * 64 + 4 * cs;
        const bool hasprev = (tok & (SEQ - 1)) != 0;
        const f32x4 yv = *(const f32x4*)(yraw + (size_t)tok * 1024 + chn);
        const u32x2 vcw = *(const u32x2*)(pE + (size_t)tok * PE_LD + 2048 + chn), gcw = *(const u32x2*)(pE + (size_t)tok * PE_LD + 3072 + chn);
        u32x2 vpw = {0u, 0u}, gpw = {0u, 0u};
        if (hasprev) { vpw = *(const u32x2*)(pE + (size_t)(tok - 1) * PE_LD + 2048 + chn); gpw = *(const u32x2*)(pE + (size_t)(tok - 1) * PE_LD + 3072 + chn); }
        const f32x4 muv = *(const f32x4*)(mu + 2048 + chn), mug = *(const f32x4*)(mu + 3072 + chn);
        const f32x4 lg = *(const f32x4*)(INF(I_EV_LNG) + le * 1024 + chn), lb = *(const f32x4*)(INF(I_EV_LNB) + le * 1024 + chn);
        const float bo = bonus[(size_t)tok * 16 + h];
        const float mean = row16_sum(yv[0] + yv[1] + yv[2] + yv[3]) * (1.0f / 64.0f);
        const f32x4 d = yv - mean;
        const float var = row16_sum(d[0] * d[0] + d[1] * d[1] + d[2] * d[2] + d[3] * d[3]) * (1.0f / 64.0f);
        const float rstd = rsqrtf(var + LNX_EPS);
        float vc[4] = {__uint_as_float(vcw[0] << 16), __uint_as_float(vcw[0] & 0xffff0000u), __uint_as_float(vcw[1] << 16), __uint_as_float(vcw[1] & 0xffff0000u)};
        float gc[4] = {__uint_as_float(gcw[0] << 16), __uint_as_float(gcw[0] & 0xffff0000u), __uint_as_float(gcw[1] << 16), __uint_as_float(gcw[1] & 0xffff0000u)};
        float vp[4] = {__uint_as_float(vpw[0] << 16), __uint_as_float(vpw[0] & 0xffff0000u), __uint_as_float(vpw[1] << 16), __uint_as_float(vpw[1] & 0xffff0000u)};
        float gp[4] = {__uint_as_float(gpw[0] << 16), __uint_as_float(gpw[0] & 0xffff0000u), __uint_as_float(gpw[1] << 16), __uint_as_float(gpw[1] & 0xffff0000u)};
        float o[4];
#pragma unroll
        for (int e = 0; e < 4; ++e) {
            const float yn = d[e] * rstd * lg[e] + lb[e];
            const float vs = vc[e] + (vp[e] - vc[e]) * muv[e], gs = gc[e] + (gp[e] - gc[e]) * mug[e];
            o[e] = (yn + bo * vs) * fsilu(gs);
        }
        u32x2 w = {cvt_pk_bf16(o[0], o[1]), cvt_pk_bf16(o[2], o[3])};
        *(u32x2*)(mix + (size_t)tok * 2048 + chn) = w;
    }
}

__device__ __forceinline__ void phase_odd_prep(const int wv, const Params& P) {
    const int tid_ = launder_tid(wv); const int wave = wv, lane = tid_ & 63;
    const bf16_t* pO = (const bf16_t*)(P.ws + OFF_P);
    const float* tab = (const float*)(P.ws + OFF_TAB);
    bf16_t* kpe = (bf16_t*)(P.ws + OFF_KPE);
    float* rsq = (float*)(P.ws + OFF_RSQ);
    float* rskv = (float*)(P.ws + OFF_RSKV);
    for (int tok = blockIdx.x * 8 + wave; tok < T_TOK; tok += gridDim.x * 8) {
        const bf16_t* row = pO + (size_t)tok * PO_LD;
        float a[8], bq[8];
        unpack8(*(const u32x4*)(row + 8 * lane), a);
        unpack8(*(const u32x4*)(row + 512 + 8 * lane), bq);
        float s1 = 0.f, s2 = 0.f;
#pragma unroll
        for (int i = 0; i < 8; ++i) { s1 += a[i] * a[i]; s2 += bq[i] * bq[i]; }
        s1 = wave_sum(s1); s2 = wave_sum(s2);
        if (lane == 0) { rsq[tok] = rsqrtf(s1 * (1.0f / 512.0f) + NORM_EPS); rskv[tok] = rsqrtf(s2 * (1.0f / 512.0f) + NORM_EPS); }
        if (lane < 32) {
            const float t1 = bf2f(row[3072 + lane]), t2 = bf2f(row[3072 + 32 + lane]);
            const f32x2 cs = *(const f32x2*)(tab + ((size_t)tok * 32 + lane) * 2);
            const float o1 = t1 * cs[0] - t2 * cs[1], o2 = t2 * cs[0] + t1 * cs[1];
            *(unsigned*)(kpe + (size_t)tok * 64 + 2 * lane) = cvt_pk_bf16(o1, o2);
        }
    }
}

__device__ __forceinline__ void phase_attn(const int wv, const Params& P, LAS unsigned char* lds) {
    const int wave = wv;
    const bf16_t* q = (const bf16_t*)(P.ws + OFF_Q);
    const bf16_t* kn = (const bf16_t*)(P.ws + OFF_KV);
    const bf16_t* vT = kn + (size_t)T_TOK * 2048;
    const bf16_t* kpe = (const bf16_t*)(P.ws + OFF_KPE);
    const bf16_t* pO = (const bf16_t*)(P.ws + OFF_P);
    bf16_t* mix = (bf16_t*)(P.ws + OFF_ZM);
    constexpr int KB_BYTES = 64 * 400, VB_BYTES = 128 * 144, VB0 = 2 * KB_BYTES;
    for (int it = blockIdx.x; it < 1024; it += gridDim.x) {
        const int tid = launder_tid(wv), lane = tid & 63, c = lane & 15, gq = lane >> 4;
        const int k4 = it >> 8, blk = it & 255, bh = blk & 63, qd = blk >> 6, b = bh >> 4, h = bh & 15;
        const int qb = (k4 == 0) ? 15 - qd : (k4 == 1) ? 11 - qd : (k4 == 2) ? 4 + qd : qd;
        const int q0 = 256 * qb + 32 * wave;
        bf16x8 Qf[2][6];
#pragma unroll
        for (int sb = 0; sb < 2; ++sb)
#pragma unroll
            for (int ks = 0; ks < 6; ++ks) Qf[sb][ks] = *(const bf16x8*)(q + (size_t)(b * SEQ + q0 + 16 * sb + c) * 3072 + h * 192 + 32 * ks + 8 * gq);
        f32x4 o[2][8];
#pragma unroll
        for (int sb = 0; sb < 2; ++sb)
#pragma unroll
            for (int db = 0; db < 8; ++db) o[sb][db] = (f32x4){0.f, 0.f, 0.f, 0.f};
        float mrun[2] = {-1e30f, -1e30f}, lrun[2] = {0.f, 0.f};
        const int ntiles = 4 * qb + 4;
        const int kr0 = tid >> 4, kc0 = tid & 15, pr0 = tid >> 3, pc0 = tid & 7;
        const bf16_t* knb = kn + (size_t)(b * SEQ) * 2048 + h * 128 + kc0 * 8;
        const bf16_t* kpb = kpe + (size_t)(b * SEQ) * 64 + pc0 * 8;
        const bf16_t* vtb = vT + (size_t)(h * 128) * T_TOK + b * SEQ + pc0 * 8;
        u32x4 sk0, sk1, sk2, sv0, sv1;
#define ATT_LOAD(kt) do { const int kbase = 64 * (kt); \
        sk0 = *(const u32x4*)(knb + (size_t)(kbase + kr0) * 2048); sk1 = *(const u32x4*)(knb + (size_t)(kbase + kr0 + 32) * 2048); \
        sk2 = *(const u32x4*)(kpb + (size_t)(kbase + pr0) * 64); \
        sv0 = *(const u32x4*)(vtb + (size_t)pr0 * T_TOK + kbase); sv1 = *(const u32x4*)(vtb + (size_t)(pr0 + 64) * T_TOK + kbase); } while (0)
#define ATT_STORE(buf) do { LAS unsigned char* kd = lds + (buf) * KB_BYTES; LAS unsigned char* vd = lds + VB0 + (buf) * VB_BYTES; \
        *(LAS u32x4*)(kd + kr0 * 400 + kc0 * 16) = sk0; *(LAS u32x4*)(kd + (kr0 + 32) * 400 + kc0 * 16) = sk1; \
        *(LAS u32x4*)(kd + pr0 * 400 + 256 + pc0 * 16) = sk2; \
        *(LAS u32x4*)(vd + pr0 * 144 + pc0 * 16) = sv0; *(LAS u32x4*)(vd + (pr0 + 64) * 144 + pc0 * 16) = sv1; } while (0)
        ATT_LOAD(0);
        ATT_STORE(0);
        __syncthreads();
        for (int kt = 0; kt < ntiles; ++kt) {
            const int buf = kt & 1;
            bool loaded = false;
            if (64 * kt <= q0 + 31) {
                const LAS unsigned char* kd = lds + buf * KB_BYTES;
                const LAS unsigned char* vd = lds + VB0 + buf * VB_BYTES;
                f32x4 s[2][4];
#pragma unroll
                for (int sb = 0; sb < 2; ++sb)
#pragma unroll
                    for (int kb = 0; kb < 4; ++kb) s[sb][kb] = (f32x4){0.f, 0.f, 0.f, 0.f};
                {
                    const LAS unsigned char* kbase = kd + c * 400 + gq * 16;
                    bf16x8 kfA[6], kfB[6];
#pragma unroll
                    for (int ks = 0; ks < 6; ++ks) kfA[ks] = *(const LAS bf16x8*)(kbase + ks * 64);
#pragma unroll
                    for (int ks = 0; ks < 6; ++ks) kfB[ks] = *(const LAS bf16x8*)(kbase + 6400 + ks * 64);
                    __builtin_amdgcn_sched_barrier(0);
#pragma unroll
                    for (int ks = 0; ks < 6; ++ks) { s[0][0] = MFMA16(kfA[ks], Qf[0][ks], s[0][0]); s[1][0] = MFMA16(kfA[ks], Qf[1][ks], s[1][0]); }
                    __builtin_amdgcn_sched_barrier(0);
#pragma unroll
                    for (int ks = 0; ks < 6; ++ks) kfA[ks] = *(const LAS bf16x8*)(kbase + 12800 + ks * 64);
                    __builtin_amdgcn_sched_barrier(0);
#pragma unroll
                    for (int ks = 0; ks < 6; ++ks) { s[0][1] = MFMA16(kfB[ks], Qf[0][ks], s[0][1]); s[1][1] = MFMA16(kfB[ks], Qf[1][ks], s[1][1]); }
                    __builtin_amdgcn_sched_barrier(0);
#pragma unroll
                    for (int ks = 0; ks < 6; ++ks) kfB[ks] = *(const LAS bf16x8*)(kbase + 19200 + ks * 64);
                    __builtin_amdgcn_sched_barrier(0);
#pragma unroll
                    for (int ks = 0; ks < 6; ++ks) { s[0][2] = MFMA16(kfA[ks], Qf[0][ks], s[0][2]); s[1][2] = MFMA16(kfA[ks], Qf[1][ks], s[1][2]); }
                    __builtin_amdgcn_sched_barrier(0);
#pragma unroll
                    for (int ks = 0; ks < 6; ++ks) { s[0][3] = MFMA16(kfB[ks], Qf[0][ks], s[0][3]); s[1][3] = MFMA16(kfB[ks], Qf[1][ks], s[1][3]); }
                    __builtin_amdgcn_sched_barrier(0);
                }
                if (64 * kt + 63 > q0) {
#pragma unroll
                    for (int sb = 0; sb < 2; ++sb)
#pragma unroll
                        for (int kb = 0; kb < 4; ++kb)
#pragma unroll
                            for (int j = 0; j < 4; ++j) { const int key = 64 * kt + 16 * kb + 4 * gq + j, qrow = q0 + 16 * sb + c; if (key > qrow) s[sb][kb][j] = -__builtin_inff(); }
                }
                if (kt + 1 < ntiles) { ATT_LOAD(kt + 1); loaded = true; }
                bf16x8 pf[2][2];
#pragma unroll
                for (int sb = 0; sb < 2; ++sb) {
                    float mx = s[sb][0][0];
#pragma unroll
                    for (int kb = 0; kb < 4; ++kb)
#pragma unroll
                        for (int j = 0; j < 4; ++j) mx = fmaxf(mx, s[sb][kb][j]);
                    mx = fmaxf(mx, __shfl_xor(mx, 16)); mx = fmaxf(mx, __shfl_xor(mx, 32));
                    const float mnew = fmaxf(mrun[sb], mx);
                    const float alpha = ex2(mrun[sb] - mnew);
                    mrun[sb] = mnew;
                    float psum = 0.f;
#pragma unroll
                    for (int kb = 0; kb < 4; ++kb)
#pragma unroll
                        for (int j = 0; j < 4; ++j) { const float pv = ex2(s[sb][kb][j] - mnew); s[sb][kb][j] = pv; psum += pv; }
                    lrun[sb] = lrun[sb] * alpha + psum;
                    if (__builtin_amdgcn_ballot_w64(alpha != 1.0f) != 0ull) {
#pragma unroll
                        for (int db = 0; db < 8; ++db) o[sb][db] *= alpha;
                    }
                    pf[sb][0] = pack8(s[sb][0], s[sb][1]); pf[sb][1] = pack8(s[sb][2], s[sb][3]);
                }
                {
                    const LAS unsigned char* vbase = vd + c * 144 + gq * 8;
#define VFRAG(db_, ks2_) ({ const u32x2 lo_ = *(const LAS u32x2*)(vbase + (db_) * 2304 + (ks2_) * 64); const u32x2 hi_ = *(const LAS u32x2*)(vbase + (db_) * 2304 + (ks2_) * 64 + 32); \
                            u32x4 w_ = {lo_[0], lo_[1], hi_[0], hi_[1]}; *reinterpret_cast<bf16x8*>(&w_); })
                    bf16x8 vA0 = VFRAG(0, 0), vA1 = VFRAG(0, 1), vB0 = VFRAG(1, 0), vB1 = VFRAG(1, 1);
                    __builtin_amdgcn_sched_barrier(0);
#pragma unroll
                    for (int db = 0; db < 8; db += 2) {
                        o[0][db] = MFMA16(vA0, pf[0][0], o[0][db]); o[1][db] = MFMA16(vA0, pf[1][0], o[1][db]);
                        o[0][db] = MFMA16(vA1, pf[0][1], o[0][db]); o[1][db] = MFMA16(vA1, pf[1][1], o[1][db]);
                        __builtin_amdgcn_sched_barrier(0);
                        if (db + 2 < 8) { vA0 = VFRAG(db + 2, 0); vA1 = VFRAG(db + 2, 1); }
                        __builtin_amdgcn_sched_barrier(0);
                        o[0][db + 1] = MFMA16(vB0, pf[0][0], o[0][db + 1]); o[1][db + 1] = MFMA16(vB0, pf[1][0], o[1][db + 1]);
                        o[0][db + 1] = MFMA16(vB1, pf[0][1], o[0][db + 1]); o[1][db + 1] = MFMA16(vB1, pf[1][1], o[1][db + 1]);
                        __builtin_amdgcn_sched_barrier(0);
                        if (db + 3 < 8) { vB0 = VFRAG(db + 3, 0); vB1 = VFRAG(db + 3, 1); }
                        __builtin_amdgcn_sched_barrier(0);
                    }
#undef VFRAG
                }
            }
            if (kt + 1 < ntiles) { if (!loaded) ATT_LOAD(kt + 1); ATT_STORE(buf ^ 1); }
            __syncthreads();
        }
#undef ATT_LOAD
#undef ATT_STORE
#pragma unroll
        for (int sb = 0; sb < 2; ++sb) {
            float lt = lrun[sb]; lt += __shfl_xor(lt, 16); lt += __shfl_xor(lt, 32);
            const float inv = 1.0f / lt;
            const size_t tok = (size_t)(b * SEQ + q0 + 16 * sb + c);
#pragma unroll
            for (int db = 0; db < 8; ++db) {
                const int dv0 = 16 * db + 4 * gq;
                const u32x2 gw = *(const u32x2*)(pO + tok * PO_LD + 1024 + h * 128 + dv0);
                const float g0 = __uint_as_float(gw[0] << 16), g1 = __uint_as_float(gw[0] & 0xffff0000u), g2 = __uint_as_float(gw[1] << 16), g3 = __uint_as_float(gw[1] & 0xffff0000u);
                const f32x4 ov = o[sb][db] * inv;
                u32x2 w = {cvt_pk_bf16(ov[0] * fsilu(g0), ov[1] * fsilu(g1)), cvt_pk_bf16(ov[2] * fsilu(g2), ov[3] * fsilu(g3))};
                *(u32x2*)(mix + tok * 2048 + h * 128 + dv0) = w;
            }
        }
    }
}

#define XB_TMO      128
#define XB_XCNT(j)  (256  + 64 * (j))
#define XB_XSUB(j)  (1280 + 64 * (j))
#define XB_XGEN(j)  (2304 + 64 * (j))
#define XB_TOP      3328
#define XB_TOPGEN   3392
#define XCD_BAR_WORDS 3456
#define XB_SPIN_CAP (1u << 18)
__device__ __forceinline__ unsigned xb_ld(unsigned* p)              { return __hip_atomic_load(p, __ATOMIC_RELAXED, __HIP_MEMORY_SCOPE_AGENT); }
__device__ __forceinline__ unsigned xb_add(unsigned* p, unsigned v) { return __hip_atomic_fetch_add(p, v, __ATOMIC_RELAXED, __HIP_MEMORY_SCOPE_AGENT); }
__device__ __forceinline__ unsigned xb_xcc_id() { return (unsigned)__builtin_amdgcn_s_getreg((3 << 11) | 20) & 0xFu; }
#define XB_SPIN(cond, bar) do { unsigned _sp = 0; while (cond) { __builtin_amdgcn_s_sleep(1); \
    if ((++_sp & 255u) == 0u) { if (xb_ld(&(bar)[XB_TMO])) break; if (_sp > XB_SPIN_CAP) { atomicAdd(&(bar)[XB_TMO], 1u); break; } } } } while (0)
struct XcdBarrier { unsigned* bar; unsigned x; volatile LAS unsigned* st; };
__device__ __forceinline__ XcdBarrier xcd_barrier_post(unsigned* bar, volatile LAS unsigned* st) {
    XcdBarrier b; b.bar = bar; b.x = xb_xcc_id(); b.st = st;
    if (threadIdx.x == 0) (void)xb_add(&bar[XB_XCNT(b.x)], 1u);
    return b;
}
__device__ __forceinline__ void xcd_barrier_complete(unsigned* bar, unsigned x, unsigned& nloc, unsigned& nx) {
    const unsigned G = gridDim.x * gridDim.y * gridDim.z;
    unsigned sum, cnt, mine, sp = 0u;
    for (;;) {
        sum = 0u; cnt = 0u; mine = 0u;
#pragma unroll
        for (unsigned j = 0; j < 16; ++j) { const unsigned c = xb_ld(&bar[XB_XCNT(j)]); sum += c; cnt += (c > 0u) ? 1u : 0u; mine = (j == x) ? c : mine; }
        if (sum == G) break;
        __builtin_amdgcn_s_sleep(1);
        if ((++sp & 255u) == 0u) { if (xb_ld(&bar[XB_TMO])) break; if (sp > XB_SPIN_CAP) { atomicAdd(&bar[XB_TMO], 1u); break; } }
    }
    nloc = mine > 0u ? mine : 1u; nx = cnt > 0u ? cnt : 1u;
}
__device__ __forceinline__ void xcd_barrier(const XcdBarrier& b) {
    asm volatile("s_waitcnt vmcnt(0)" ::: "memory");
    __syncthreads();
    if (threadIdx.x == 0) {
        unsigned* bar = b.bar;
        unsigned bx = b.x; asm volatile("" : "+s"(bx));
        __builtin_amdgcn_s_waitcnt(0);
        unsigned nloc = b.st[0], nx = b.st[1];
        if (nloc == 0u) { xcd_barrier_complete(bar, bx, nloc, nx); b.st[0] = nloc; b.st[1] = nx; }
        const unsigned old = xb_add(&bar[XB_XSUB(bx)], 1u);
        const unsigned gen = old / nloc;
        if (old + 1u == (gen + 1u) * nloc) {
            __builtin_amdgcn_fence(__ATOMIC_RELEASE, "agent");
            asm volatile("s_waitcnt vmcnt(0)" ::: "memory");
            const unsigned og = xb_add(&bar[XB_TOP], 1u);
            const unsigned tg = og / nx;
            if (og + 1u == (tg + 1u) * nx) xb_add(&bar[XB_TOPGEN], 1u);
            else XB_SPIN(xb_ld(&bar[XB_TOPGEN]) == tg, bar);
            __builtin_amdgcn_fence(__ATOMIC_ACQUIRE, "agent");
            xb_add(&bar[XB_XGEN(bx)], 1u);
            asm volatile("s_waitcnt vmcnt(0)" ::: "memory");
        } else {
            XB_SPIN(xb_ld(&bar[XB_XGEN(bx)]) == gen, bar);
            __builtin_amdgcn_fence(__ATOMIC_ACQUIRE, "agent");
            asm volatile("s_waitcnt vmcnt(0)" ::: "memory");
        }
    }
    __syncthreads();
}

__global__ void __launch_bounds__(512, 2) fwd_megakernel(Params P) {
    extern __shared__ __attribute__((aligned(16))) unsigned char shm_raw[];
    LAS unsigned char* lds = (LAS unsigned char*)shm_raw;
    cg::grid_group grid = cg::this_grid();
    const int wv = __builtin_amdgcn_readfirstlane((int)threadIdx.x >> 6);
    volatile LAS unsigned* xst = (volatile LAS unsigned*)(lds + (LDS_BYTES - 16));
    if (threadIdx.x == 0) { xst[0] = 0u; xst[1] = 0u; }
    __syncthreads();
    const XcdBarrier xb = xcd_barrier_post((unsigned*)(P.ws + OFF_BAR), xst);
#define GSYNC() xcd_barrier(xb)
    const float* mod = (const float*)(P.ws + OFF_MOD);
    bf16_t* zm = (bf16_t*)(P.ws + OFF_ZM);
    bf16_t* pbuf = (bf16_t*)(P.ws + OFF_P);
    bf16_t* ybuf = (bf16_t*)(P.ws + OFF_P);

    for (int r = 0; r < P.reps[8]; ++r) GSYNC();
    if (P.reps[15] == 0x7fffffff) grid.sync();
    for (int r = 0; r < P.reps[2]; ++r) { phase_prep(wv, P, lds); GSYNC(); }
    phase_resnorm(wv, P, INF(I_X), nullptr, nullptr, nullptr, INF(I_EV_NPRE), mod, zm, nullptr);
    GSYNC();

    for (int layer = 0; layer < 4; ++layer) {
        const int j = layer >> 1;
        unsigned char* we = P.ws + OFF_WBF + (size_t)j * (SZ_WE + SZ_WO);
        unsigned char* wo = we + SZ_WE;
        if ((layer & 1) == 0) {
            for (int r = 0; r < P.reps[3]; ++r) { Epi<EPI_BF16> E{}; E.O = pbuf; E.ldc = PE_LD; run_gemm<EPI_BF16>(wv, lds, zm, 2048, (const bf16_t*)(we + WE_IN), 2048, T_TOK, 6400, 2048, E);
            GSYNC(); }
            phase_da(wv, P, j); GSYNC();
            for (int r = 0; r < P.reps[0]; ++r) { phase_scan(wv, P, j, lds); GSYNC(); }
            for (int r = 0; r < P.reps[7]; ++r) {
            phase_rwkv_post(wv, P, j);
            { Epi<EPI_GLU> E{}; E.O = zm; E.ldc = 2048; E.bias = INF(I_EV_GLUB) + j * 1024; E.yg = (const bf16_t*)(P.ws + OFF_KV); E.pe = pbuf;
              run_gemm<EPI_GLU>(wv, lds, (const bf16_t*)(P.ws + OFF_KV), 1024, (const bf16_t*)(we + WE_GLU), 1024, T_TOK, 1024, 1024, E); }
            GSYNC(); }
            for (int r = 0; r < P.reps[6]; ++r) { Epi<EPI_BF16> E{}; E.O = ybuf; E.ldc = 2048; run_gemm<EPI_BF16>(wv, lds, zm, 2048, (const bf16_t*)(we + WE_OUT), 2048, T_TOK, 2048, 2048, E);
            GSYNC(); }
        } else {
            for (int r = 0; r < P.reps[4]; ++r) { Epi<EPI_BF16> E{}; E.O = pbuf; E.ldc = PO_LD; run_gemm<EPI_BF16>(wv, lds, zm, 2048, (const bf16_t*)(wo + WO_IN), 2048, T_TOK, 3328, 2048, E);
            GSYNC(); }
            phase_odd_prep(wv, P);
            GSYNC();
            for (int r = 0; r < P.reps[5]; ++r) {
            { Epi<EPI_Q> E{}; E.O = P.ws + OFF_Q; E.ldc = 3072; E.rs = (const float*)(P.ws + OFF_RSQ); E.tab = (const float*)(P.ws + OFF_TAB);
              run_gemm<EPI_Q>(wv, lds, pbuf, PO_LD, (const bf16_t*)(wo + WO_Q), 512, T_TOK, 3072, 512, E); }
            { Epi<EPI_KN> E{}; E.O = P.ws + OFF_KV; E.ldc = 2048; E.rs = (const float*)(P.ws + OFF_RSKV);
              run_gemm<EPI_KN>(wv, lds, pbuf + 512, PO_LD, (const bf16_t*)(wo + WO_K), 512, T_TOK, 2048, 512, E); }
            { Epi<EPI_VT> E{}; E.O = P.ws + OFF_KV + (size_t)T_TOK * 2048 * 2; E.ldc = T_TOK; E.rs = (const float*)(P.ws + OFF_RSKV);
              run_gemm<EPI_VT>(wv, lds, (const bf16_t*)(wo + WO_V), 512, pbuf + 512, PO_LD, 2048, T_TOK, 512, E); }
            GSYNC(); }
            for (int r = 0; r < P.reps[1]; ++r) { phase_attn(wv, P, lds); GSYNC(); }
            for (int r = 0; r < P.reps[6]; ++r) { Epi<EPI_BF16> E{}; E.O = ybuf; E.ldc = 2048; run_gemm<EPI_BF16>(wv, lds, zm, 2048, (const bf16_t*)(wo + WO_OUT), 2048, T_TOK, 2048, 2048, E);
            GSYNC(); }
        }
        {
            const float* post = ((layer & 1) ? INF(I_OD_NPOST) : INF(I_EV_NPOST)) + j * 2048;
            const float* hsrc = layer == 0 ? INF(I_X) : P.out;
            const int nl = layer + 1;
            const float* pre = nl < 4 ? (((nl & 1) ? INF(I_OD_NPRE) : INF(I_EV_NPRE)) + (nl >> 1) * 2048) : nullptr;
            phase_resnorm(wv, P, hsrc, ybuf, post, mod + (size_t)layer * 4 * 6144, pre, mod + (size_t)nl * 4 * 6144, nl < 4 ? zm : nullptr, P.out);
        }
        if (layer < 3) GSYNC();
    }
}

extern "C" void kernel_launch(void* const* d_in, const int* in_sizes, int n_in, void* d_out, int out_size, void* d_ws, size_t ws_size, hipStream_t stream) {
    static int grid_blocks = 0;
    if (!grid_blocks) {
        int dev = 0, cus = 0, per_cu = 0;
        (void)hipGetDevice(&dev);
        (void)hipDeviceGetAttribute(&cus, hipDeviceAttributeMultiprocessorCount, dev);
        (void)hipFuncSetAttribute((const void*)fwd_megakernel, hipFuncAttributeMaxDynamicSharedMemorySize, LDS_BYTES);
        (void)hipOccupancyMaxActiveBlocksPerMultiprocessor(&per_cu, fwd_megakernel, 512, LDS_BYTES);
        if (per_cu < 1) per_cu = 1;
        grid_blocks = cus * per_cu;
        if (grid_blocks > 256) grid_blocks = 256;
    }
    if (ws_size < WS_NEED) fprintf(stderr, "workspace too small: %zu < %zu\n", ws_size, (size_t)WS_NEED);
    Params p;
    memset(&p, 0, sizeof(p));
    for (int i = 0; i < n_in && i < 40; ++i) p.in[i] = d_in[i];
    for (int i = 0; i < 16; ++i) p.reps[i] = 1;
    p.reps[8] = 0;
#ifdef REP_SYNC
    p.reps[8] = REP_SYNC;
#endif
#ifdef REP_SCAN
    p.reps[0] = REP_SCAN;
#endif
#ifdef REP_ATTN
    p.reps[1] = REP_ATTN;
#endif
#ifdef REP_PREP
    p.reps[2] = REP_PREP;
#endif
#ifdef REP_G1E
    p.reps[3] = REP_G1E;
#endif
#ifdef REP_G1O
    p.reps[4] = REP_G1O;
#endif
#ifdef REP_QKV
    p.reps[5] = REP_QKV;
#endif
#ifdef REP_OUT
    p.reps[6] = REP_OUT;
#endif
#ifdef REP_GLU
    p.reps[7] = REP_GLU;
#endif
    p.out = (float*)d_out;
    p.ws = (unsigned char*)d_ws;
    (void)hipMemsetAsync((unsigned char*)d_ws + OFF_BAR, 0, 16384, stream);
    void* args[] = {&p};
    hipError_t e = hipLaunchCooperativeKernel((const void*)fwd_megakernel, dim3(grid_blocks), dim3(512), args, LDS_BYTES, stream);
    if (e != hipSuccess) fprintf(stderr, "cooperative launch failed: %s (grid %d)\n", hipGetErrorString(e), grid_blocks);
}
```

```cpp
#include <hip/hip_runtime.h>
#include <hip/hip_cooperative_groups.h>
#include <cstdio>
#include <cstdint>
#include <cstring>
namespace cg = cooperative_groups;

#define LAS __attribute__((address_space(3)))
typedef unsigned short bf16_t;
typedef short bf16x8 __attribute__((ext_vector_type(8)));
typedef float f32x4 __attribute__((ext_vector_type(4)));
typedef float f32x2 __attribute__((ext_vector_type(2)));
typedef unsigned u32x4 __attribute__((ext_vector_type(4)));
typedef unsigned u32x2 __attribute__((ext_vector_type(2)));

constexpr int T_TOK = 16384, DM = 2048, SEQ = 4096;
constexpr int PE_LD = 6400;
constexpr int PO_LD = 3328;
constexpr float NORM_EPS = 1e-6f, LNX_EPS = 64e-5f;
constexpr float QSCALE = 0.07216878364870322f * 1.4426950408889634f;

constexpr size_t SZ_WE = (size_t)6400 * 2048 * 2 + (size_t)1024 * 1024 * 2 + (size_t)2048 * 2048 * 2;
constexpr size_t SZ_WO = (size_t)3328 * 2048 * 2 + (size_t)3072 * 512 * 2 + 2 * (size_t)2048 * 512 * 2 + (size_t)2048 * 2048 * 2;
constexpr size_t OFF_WBF = 0;
constexpr size_t OFF_ZM = OFF_WBF + 2 * (SZ_WE + SZ_WO);
constexpr size_t OFF_P = OFF_ZM + (size_t)T_TOK * 2048 * 2;
constexpr size_t OFF_Q = OFF_P + (size_t)T_TOK * PO_LD * 2;
constexpr size_t OFF_KV = OFF_P + (size_t)T_TOK * PE_LD * 2;
constexpr size_t OFF_SMALL = OFF_KV + (size_t)T_TOK * 2048 * 4;
constexpr size_t OFF_MOD = OFF_SMALL;
constexpr size_t OFF_TAB = OFF_MOD + 4 * 4 * 6144 * 4;
constexpr size_t OFF_KPE = OFF_TAB + (size_t)T_TOK * 32 * 8;
constexpr size_t OFF_RSQ = OFF_KPE + (size_t)T_TOK * 64 * 2;
constexpr size_t OFF_RSKV = OFF_RSQ + (size_t)T_TOK * 4;
constexpr size_t OFF_BONUS = OFF_RSKV + (size_t)T_TOK * 4;
constexpr size_t OFF_BAR = OFF_BONUS + (size_t)T_TOK * 16 * 4;
constexpr size_t OFF_LA = OFF_BAR + 16384;
constexpr size_t WS_NEED = OFF_LA + (size_t)T_TOK * 128 * 2;
constexpr size_t WE_IN = 0, WE_GLU = (size_t)6400 * 2048 * 2, WE_OUT = WE_GLU + (size_t)1024 * 1024 * 2;
constexpr size_t WO_IN = 0, WO_Q = (size_t)3328 * 2048 * 2, WO_K = WO_Q + (size_t)3072 * 512 * 2, WO_V = WO_K + (size_t)2048 * 512 * 2, WO_OUT = WO_V + (size_t)2048 * 512 * 2;

constexpr int LDS_BYTES = 163840;

enum { I_X = 0, I_C, I_POS, I_EV_ADA_W, I_EV_ADA_B, I_EV_NPRE, I_EV_NPOST, I_EV_WIN, I_EV_MU, I_EV_W0, I_EV_W2, I_EV_A0, I_EV_A2,
       I_EV_KK, I_EV_KA, I_EV_RK, I_EV_LNG, I_EV_LNB, I_EV_LRE, I_EV_LIM, I_EV_LOGDT, I_EV_BRE, I_EV_BIM, I_EV_CRE, I_EV_CIM, I_EV_D,
       I_EV_GLUW, I_EV_GLUB, I_EV_WOUT, I_OD_ADA_W, I_OD_ADA_B, I_OD_NPRE, I_OD_NPOST, I_OD_WIN, I_OD_QN, I_OD_WQ, I_OD_KVN, I_OD_WKV, I_OD_WOUT, N_IN };

struct Params {
    const void* in[40];
    float* out;
    unsigned char* ws;
    int reps[16];
};
#define INF(i) ((const float*)P.in[i])

__device__ __forceinline__ float bf2f(bf16_t v) { return __uint_as_float(((unsigned)v) << 16); }
typedef __bf16 bf16v2_t __attribute__((ext_vector_type(2)));
__device__ __forceinline__ unsigned cvt_pk_bf16(float lo, float hi) { const f32x2 v = {lo, hi}; const bf16v2_t r = __builtin_convertvector(v, bf16v2_t); return __builtin_bit_cast(unsigned, r); }
__device__ __forceinline__ bf16_t f2bf(float f) { return (bf16_t)(cvt_pk_bf16(f, 0.f) & 0xffffu); }
__device__ __forceinline__ bf16x8 pack8(f32x4 a, f32x4 b) { u32x4 w = {cvt_pk_bf16(a[0], a[1]), cvt_pk_bf16(a[2], a[3]), cvt_pk_bf16(b[0], b[1]), cvt_pk_bf16(b[2], b[3])}; return *reinterpret_cast<bf16x8*>(&w); }
__device__ __forceinline__ void unpack8(u32x4 w, float* f) {
#pragma unroll
    for (int i = 0; i < 4; ++i) { f[2 * i] = __uint_as_float(w[i] << 16); f[2 * i + 1] = __uint_as_float(w[i] & 0xffff0000u); }
}
__device__ __forceinline__ float ex2(float x) { return __builtin_amdgcn_exp2f(x); }
__device__ __forceinline__ float fexp(float x) { return __builtin_amdgcn_exp2f(x * 1.4426950408889634f); }
__device__ __forceinline__ float flog(float x) { return __builtin_amdgcn_logf(x) * 0.6931471805599453f; }
__device__ __forceinline__ float fsigmoid(float x) { return __builtin_amdgcn_rcpf(1.0f + fexp(-x)); }
__device__ __forceinline__ float fsilu(float x) { return x * fsigmoid(x); }
__device__ __forceinline__ float ftanh(float x) { return 1.0f - 2.0f * __builtin_amdgcn_rcpf(1.0f + fexp(2.0f * x)); }
__device__ __forceinline__ float fsoftplus(float x) { return fmaxf(x, 0.f) + flog(1.0f + fexp(-fabsf(x))); }
__device__ __forceinline__ float fgelu(float x) { return 0.5f * x * (1.0f + ftanh(0.7978845608028654f * (x + 0.044715f * x * x * x))); }
template <int CTRL> __device__ __forceinline__ float dppf(float v) { return __int_as_float(__builtin_amdgcn_update_dpp(0, __float_as_int(v), CTRL, 0xF, 0xF, true)); }
__device__ __forceinline__ float row16_sum(float v) { v += dppf<0xB1>(v); v += dppf<0x4E>(v); v += dppf<0x124>(v); v += dppf<0x128>(v); return v; }
__device__ __forceinline__ float wave_sum(float v) { v = row16_sum(v); v += __shfl_xor(v, 16); v += __shfl_xor(v, 32); return v; }
__device__ __forceinline__ int launder_tid(int wv) { int t = wv * 64 + (int)__builtin_amdgcn_mbcnt_hi(~0u, __builtin_amdgcn_mbcnt_lo(~0u, 0u)); asm volatile("" : "+v"(t)); return t; }
__device__ __forceinline__ unsigned launder_u(unsigned v) { asm volatile("" : "+v"(v)); return v; }
__device__ __forceinline__ float xrow_max(float v) {
    auto a = __builtin_amdgcn_permlane16_swap(__float_as_uint(v), __float_as_uint(v), false, false);
    v = fmaxf(__uint_as_float(a[0]), __uint_as_float(a[1]));
    auto b = __builtin_amdgcn_permlane32_swap(__float_as_uint(v), __float_as_uint(v), false, false);
    return fmaxf(__uint_as_float(b[0]), __uint_as_float(b[1]));
}
__device__ __forceinline__ float xrow_sum(float v) {
    auto a = __builtin_amdgcn_permlane16_swap(__float_as_uint(v), __float_as_uint(v), false, false);
    v = __uint_as_float(a[0]) + __uint_as_float(a[1]);
    auto b = __builtin_amdgcn_permlane32_swap(__float_as_uint(v), __float_as_uint(v), false, false);
    return __uint_as_float(b[0]) + __uint_as_float(b[1]);
}
#define WAVE_SYNC() do { asm volatile("s_waitcnt lgkmcnt(0)" ::: "memory"); __builtin_amdgcn_wave_barrier(); } while (0)
#define MFMA16(a, b, c) __builtin_amdgcn_mfma_f32_16x16x32_bf16(a, b, c, 0, 0, 0)

namespace pg8 {
constexpr int BM = 256, BK = 64, HALF = 128, HTB = HALF * BK * 2, STAGE_BYTES = 8 * HTB, NXCD = 8, WGM = 8;
__device__ __forceinline__ int lds_byte(int r, int c) { const int st = (r >> 4) * 2 + (c >> 5), rr = r & 15, cc = c & 31, ob = rr * 64 + cc * 2; return st * 1024 + (ob ^ (((ob >> 9) & 1) << 5)); }
__device__ __forceinline__ void stage_rc(int b, int& R, int& C) { const int st = b / 1024, sb = b % 1024, swz = sb ^ (((sb >> 9) & 1) << 5); R = (st >> 1) * 16 + swz / 64; C = (st & 1) * 32 + (swz % 64) / 2; }
__device__ __forceinline__ int perm32(int rho) { const int n = rho >> 4, i = rho & 15; return 8 * (i >> 2) + 4 * n + (i & 3); }
struct Unit { int pm, pn; };
struct Gemm { const bf16_t* A; const bf16_t* Bt; int M, N, K, lda, ldb; };
struct StaticOrder {
    int nM, nN, nwg, G, c;
    __device__ void init(int M, int N, int G_, int c_) { nM = M / BM; nN = N / BM; nwg = nM * nN; G = G_; c = c_; }
    __device__ bool next(int i, Unit& u) const {
        const long L = (long)i * G + c; if (L >= nwg) return false;
        int wgid = (int)L; { const int q = nwg / NXCD, r = nwg % NXCD, xcd = wgid % NXCD, off = wgid / NXCD; wgid = (xcd < r ? xcd * (q + 1) : r * (q + 1) + (xcd - r) * q) + off; }
        const int nig = WGM * nN, gid = wgid / nig, fm = gid * WGM, gsz = (nM - fm) < WGM ? (nM - fm) : WGM;
        u.pm = fm + ((wgid % nig) % gsz); u.pn = (wgid % nig) / gsz; return true;
    }
};

template <class Epi>
__device__ __forceinline__ void gemm_phase(const int wv, LAS unsigned char* lds, const Gemm g, const StaticOrder& S, const Epi& E) {
    const int tid = launder_tid(wv), wid = wv, lane = tid & 63, wr = wid >> 2, wc = wid & 3, fr = lane & 15, fq = lane >> 4;
    const int K = g.K, nt = K / BK;
    unsigned voffA[2], voffB[2];
#pragma unroll
    for (int i = 0; i < 2; ++i) { int R, C; stage_rc(tid * 16 + i * 8192, R, C); const int Rb = Epi::PERM ? ((R & ~31) + perm32(R & 31)) : R;
        voffA[i] = (unsigned)(R * g.lda + C) * 2u; voffB[i] = (unsigned)(Rb * g.ldb + C) * 2u; }
    const size_t kstep = (size_t)(BK * 2);
    const size_t hstepA = (size_t)HALF * g.lda * 2, hstepB = (size_t)HALF * g.ldb * 2;
    const size_t tstepA = 2 * hstepA, tstepB = 2 * hstepB;
    const unsigned ldsw = (unsigned)wid * 1024u;
    const int aoff = lds_byte(wr * 64 + fr, fq * 8), boff = lds_byte(wc * 32 + fr, fq * 8);
#define PG8_SA(b, h) (((b) * 2 + (h)) * HTB)
#define PG8_SB(b, h) ((4 + (b) * 2 + (h)) * HTB)
#define PG8_STAGE(bufoff, gbase, voff) do { _Pragma("unroll") for (int _i = 0; _i < 2; ++_i) \
        __builtin_amdgcn_global_load_lds((const unsigned*)((const char*)(gbase) + (voff)[_i]), (LAS unsigned*)(lds + (bufoff) + ldsw + _i * 8192), 16, 0, 0); } while (0)
#define PG8_LDA(dst, b, h) do { _Pragma("unroll") for (int m = 0; m < 4; ++m) _Pragma("unroll") for (int k = 0; k < 2; ++k) dst[m][k] = *(const LAS bf16x8*)(lds + PG8_SA(b, h) + aoff + m * 2048 + k * 1024); } while (0)
#define PG8_LDB(dst, b, h) do { _Pragma("unroll") for (int n = 0; n < 2; ++n) _Pragma("unroll") for (int k = 0; k < 2; ++k) dst[n][k] = *(const LAS bf16x8*)(lds + PG8_SB(b, h) + boff + n * 2048 + k * 1024); } while (0)
#define PG8_MMA(ai, bj, At, Bt) do { __builtin_amdgcn_s_setprio(1); _Pragma("unroll") for (int m = 0; m < 4; ++m) _Pragma("unroll") for (int n = 0; n < 2; ++n) _Pragma("unroll") for (int k = 0; k < 2; ++k) \
        acc[ai][bj][m][n] = __builtin_amdgcn_mfma_f32_16x16x32_bf16(Bt[n][k], At[m][k], acc[ai][bj][m][n], 0, 0, 0); __builtin_amdgcn_s_setprio(0); } while (0)
#define PG8_WAIT_V(n) asm volatile("s_waitcnt vmcnt(" #n ")" ::: "memory")
#define PG8_WAIT_L(n) asm volatile("s_waitcnt lgkmcnt(" #n ")" ::: "memory")
#define PG8_BAR __builtin_amdgcn_s_barrier()
#define PG8_SCHED __builtin_amdgcn_sched_barrier(0)
    Unit cur, nxt; int ui = 0;
    if (!S.next(0, cur)) return;
    f32x4 acc[2][2][4][2];
#pragma unroll
    for (int a = 0; a < 2; ++a)
#pragma unroll
        for (int b = 0; b < 2; ++b)
#pragma unroll
            for (int m = 0; m < 4; ++m)
#pragma unroll
                for (int n = 0; n < 2; ++n) acc[a][b][m][n] = (f32x4){0.f, 0.f, 0.f, 0.f};
    bf16x8 At[4][2], B0[2][2], B1[2][2];
    const char* cA = (const char*)g.A + (size_t)cur.pm * tstepA; const char* cB = (const char*)g.Bt + (size_t)cur.pn * tstepB;
    PG8_STAGE(PG8_SB(0, 0), cB, voffB); PG8_STAGE(PG8_SA(0, 0), cA, voffA); PG8_STAGE(PG8_SB(0, 1), cB + hstepB, voffB); PG8_STAGE(PG8_SA(0, 1), cA + hstepA, voffA);
    if (wr == 1) PG8_BAR;
    PG8_WAIT_V(4); PG8_BAR;
    PG8_STAGE(PG8_SB(1, 0), cB + kstep, voffB); PG8_STAGE(PG8_SA(1, 0), cA + kstep, voffA); PG8_STAGE(PG8_SB(1, 1), cB + hstepB + kstep, voffB);
    PG8_WAIT_V(6); PG8_BAR;
    for (;;) {
        const bool has_next = S.next(ui + 1, nxt);
        const char* nA = has_next ? (const char*)g.A + (size_t)nxt.pm * tstepA : cA; const char* nB = has_next ? (const char*)g.Bt + (size_t)nxt.pn * tstepB : cB;
        for (int t = 0; t < nt; t += 2) {
            const bool last = (t == nt - 2);
            const char* a1 = cA + (size_t)(t + 1) * kstep;
            const char* a2 = last ? nA : cA + (size_t)(t + 2) * kstep; const char* b2 = last ? nB : cB + (size_t)(t + 2) * kstep;
            const char* a3 = a2 + kstep; const char* b3 = b2 + kstep;
            PG8_LDB(B0, 0, 0); PG8_SCHED; PG8_LDA(At, 0, 0); PG8_STAGE(PG8_SA(1, 1), a1 + hstepA, voffA);
            PG8_WAIT_L(8); PG8_BAR; PG8_WAIT_L(0); PG8_MMA(0, 0, At, B0); PG8_BAR; PG8_SCHED;
            PG8_LDB(B1, 0, 1); PG8_STAGE(PG8_SB(0, 0), b2, voffB);
            PG8_BAR; PG8_WAIT_L(0); PG8_MMA(0, 1, At, B1); PG8_BAR;
            PG8_LDA(At, 0, 1); PG8_STAGE(PG8_SA(0, 0), a2, voffA);
            PG8_BAR; PG8_WAIT_L(0); PG8_MMA(1, 0, At, B0); PG8_BAR; PG8_SCHED;
            PG8_STAGE(PG8_SB(0, 1), b2 + hstepB, voffB);
            PG8_WAIT_V(6); PG8_BAR; PG8_MMA(1, 1, At, B1); PG8_BAR;
            PG8_LDB(B0, 1, 0); PG8_SCHED; PG8_LDA(At, 1, 0); PG8_STAGE(PG8_SA(0, 1), a2 + hstepA, voffA);
            PG8_WAIT_L(8); PG8_BAR; PG8_WAIT_L(0); PG8_MMA(0, 0, At, B0); PG8_BAR; PG8_SCHED;
            PG8_LDB(B1, 1, 1); PG8_STAGE(PG8_SB(1, 0), b3, voffB);
            PG8_BAR; PG8_WAIT_L(0); PG8_MMA(0, 1, At, B1); PG8_BAR;
            PG8_LDA(At, 1, 1); PG8_STAGE(PG8_SA(1, 0), a3, voffA);
            PG8_BAR; PG8_WAIT_L(0); PG8_MMA(1, 0, At, B0); PG8_BAR; PG8_SCHED;
            PG8_STAGE(PG8_SB(1, 1), b3 + hstepB, voffB);
            PG8_WAIT_V(6); PG8_BAR; PG8_MMA(1, 1, At, B1); PG8_BAR;
        }
        E(acc, cur, wr, wc, fr, fq);
        if (!has_next) break;
#pragma unroll
        for (int a = 0; a < 2; ++a)
#pragma unroll
            for (int b = 0; b < 2; ++b)
#pragma unroll
                for (int m = 0; m < 4; ++m)
#pragma unroll
                    for (int n = 0; n < 2; ++n) acc[a][b][m][n] = (f32x4){0.f, 0.f, 0.f, 0.f};
        cur = nxt; cA = nA; cB = nB; ++ui;
    }
    PG8_WAIT_V(0);
    if (wr == 0) PG8_BAR;
    PG8_BAR;
#undef PG8_SA
#undef PG8_SB
#undef PG8_STAGE
#undef PG8_LDA
#undef PG8_LDB
#undef PG8_MMA
#undef PG8_WAIT_V
#undef PG8_WAIT_L
#undef PG8_BAR
#undef PG8_SCHED
}
}

enum { EPI_BF16 = 0, EPI_F32 = 1, EPI_Q = 2, EPI_KN = 3, EPI_VT = 4, EPI_GLU = 5 };
template <int MODE> struct Epi {
    static constexpr bool PERM = (MODE != EPI_F32);
    void* O; int ldc;
    const float* rs;
    const float* tab;
    const float* bias;
    const bf16_t* yg;
    const bf16_t* pe;
    __device__ __forceinline__ void operator()(const f32x4 (&acc)[2][2][4][2], const pg8::Unit& u, int wr, int wc, int fr, int fq) const {
        const int row0 = u.pm * 256 + wr * 64 + fr;
        if constexpr (MODE == EPI_F32) {
            const int col0 = u.pn * 256 + wc * 32 + 4 * fq;
#pragma unroll
            for (int ai = 0; ai < 2; ++ai)
#pragma unroll
                for (int m = 0; m < 4; ++m) { float* rowp = (float*)O + (size_t)(row0 + ai * 128 + m * 16) * ldc + col0;
#pragma unroll
                    for (int bj = 0; bj < 2; ++bj)
#pragma unroll
                        for (int n = 0; n < 2; ++n) *(f32x4*)(rowp + bj * 128 + n * 16) = acc[ai][bj][m][n]; }
        } else {
            const int colb = u.pn * 256 + wc * 32 + 8 * fq;
#pragma unroll
            for (int ai = 0; ai < 2; ++ai)
#pragma unroll
                for (int m = 0; m < 4; ++m) {
                    const int row = row0 + ai * 128 + m * 16;
                    float rsc = 1.f;
                    if constexpr (MODE == EPI_Q) rsc = rs[row] * QSCALE;
                    if constexpr (MODE == EPI_KN) rsc = rs[row];
#pragma unroll
                    for (int bj = 0; bj < 2; ++bj) {
                        const int col = colb + bj * 128;
                        f32x4 v0 = acc[ai][bj][m][0], v1 = acc[ai][bj][m][1];
                        if constexpr (MODE == EPI_Q || MODE == EPI_KN) { v0 *= rsc; v1 *= rsc; }
                        if constexpr (MODE == EPI_Q) {
                            const int off = col % 192;
                            if (off >= 128) {
                                const int i0 = (off - 128) >> 1;
                                const f32x4 cs0 = *(const f32x4*)(tab + ((size_t)row * 32 + i0) * 2), cs1 = *(const f32x4*)(tab + ((size_t)row * 32 + i0 + 2) * 2);
                                f32x4 r0, r1;
                                r0[0] = v0[0] * cs0[0] - v0[1] * cs0[1]; r0[1] = v0[1] * cs0[0] + v0[0] * cs0[1];
                                r0[2] = v0[2] * cs0[2] - v0[3] * cs0[3]; r0[3] = v0[3] * cs0[2] + v0[2] * cs0[3];
                                r1[0] = v1[0] * cs1[0] - v1[1] * cs1[1]; r1[1] = v1[1] * cs1[0] + v1[0] * cs1[1];
                                r1[2] = v1[2] * cs1[2] - v1[3] * cs1[3]; r1[3] = v1[3] * cs1[2] + v1[2] * cs1[3];
                                v0 = r0; v1 = r1;
                            }
                        }
                        if constexpr (MODE == EPI_VT) {
                            const f32x4 s0 = *(const f32x4*)(rs + col), s1 = *(const f32x4*)(rs + col + 4);
                            v0 *= s0; v1 *= s1;
                        }
                        if constexpr (MODE == EPI_GLU) {
                            const f32x4 b0 = *(const f32x4*)(bias + col), b1 = *(const f32x4*)(bias + col + 4);
                            float yv[8], gv[8];
                            unpack8(*(const u32x4*)(yg + (size_t)row * 1024 + col), yv);
                            unpack8(*(const u32x4*)(pe + (size_t)row * PE_LD + 5120 + col), gv);
#pragma unroll
                            for (int e = 0; e < 4; ++e) { v0[e] = yv[e] * fsigmoid(v0[e] + b0[e]) * fsilu(gv[e]); v1[e] = yv[4 + e] * fsigmoid(v1[e] + b1[e]) * fsilu(gv[4 + e]); }
                            *(bf16x8*)((bf16_t*)O + (size_t)row * ldc + 1024 + col) = pack8(v0, v1);
                        } else {
                            *(bf16x8*)((bf16_t*)O + (size_t)row * ldc + col) = pack8(v0, v1);
                        }
                    }
                }
        }
    }
};

template <int MODE>
__device__ __forceinline__ void run_gemm(const int wv, LAS unsigned char* lds, const bf16_t* A, int lda, const bf16_t* Bt, int ldb, int M, int N, int K, const Epi<MODE>& E) {
    pg8::Gemm g; g.A = A; g.Bt = Bt; g.M = M; g.N = N; g.K = K; g.lda = lda; g.ldb = ldb;
    pg8::StaticOrder S; S.init(M, N, (int)gridDim.x, (int)blockIdx.x);
    pg8::gemm_phase<Epi<MODE>>(wv, lds, g, S, E);
}

__device__ __forceinline__ void convert_job(const int wv, const float* src, int srcLd, int K, bf16_t* dst, int nDstTiles, int type, const float* kscale, LAS float* tile) {
    const int tid = launder_tid(wv), kT = K >> 6, total = nDstTiles * kT;
    for (int tix = blockIdx.x; tix < total; tix += gridDim.x) {
        const int dt = tix / kT, k0 = (tix % kT) * 64, d0 = dt * 64;
        int sc; bool perm = false;
        if (type == 0) sc = d0;
        else if (type == 1) sc = d0 < 4096 ? d0 : (d0 < 6144 ? d0 + 128 : (d0 < 6272 ? d0 - 6144 + 4096 : -1));
        else if (type == 2) sc = d0 < 1024 ? d0 : (d0 < 3072 ? d0 + 64 : (d0 < 3136 ? 1024 + (d0 - 3072) : -1));
        else if (type == 3) { const int head = dt / 3, part = dt % 3; sc = head * 192 + part * 64; perm = (part == 2); }
        else if (type == 4) { const int head = dt >> 1, part = dt & 1; sc = head * 256 + part * 64; }
        else { const int head = dt >> 1, part = dt & 1; sc = head * 256 + 128 + part * 64; }
        __syncthreads();
        if (sc >= 0) {
            const int kr = tid >> 4, c4 = (tid & 15) * 4;
#pragma unroll
            for (int i = 0; i < 2; ++i) {
                const int k = kr + 32 * i;
                f32x4 v = *(const f32x4*)(src + (size_t)(k0 + k) * srcLd + sc + c4);
                if (kscale) v *= kscale[k0 + k];
                tile[k * 65 + c4] = v[0]; tile[k * 65 + c4 + 1] = v[1]; tile[k * 65 + c4 + 2] = v[2]; tile[k * 65 + c4 + 3] = v[3];
            }
        }
        __syncthreads();
        const int row = tid >> 3, kc = (tid & 7) * 8;
        f32x4 a = {0.f, 0.f, 0.f, 0.f}, b = {0.f, 0.f, 0.f, 0.f};
        if (sc >= 0) {
            const int scol = perm ? ((row >> 1) + 32 * (row & 1)) : row;
#pragma unroll
            for (int e = 0; e < 4; ++e) { a[e] = tile[(kc + e) * 65 + scol]; b[e] = tile[(kc + 4 + e) * 65 + scol]; }
        }
        *(bf16x8*)(dst + (size_t)(d0 + row) * K + k0 + kc) = pack8(a, b);
    }
}

__device__ __forceinline__ void phase_prep(const int wv, const Params& P, LAS unsigned char* lds) {
    LAS float* tile = (LAS float*)lds;
    bf16_t* wbf = (bf16_t*)(P.ws + OFF_WBF);
    for (int lp = 0; lp < 2; ++lp) {
        unsigned char* we = P.ws + OFF_WBF + (size_t)lp * (SZ_WE + SZ_WO);
        unsigned char* wo = we + SZ_WE;
        convert_job(wv, INF(I_EV_WIN) + (size_t)lp * 2048 * 6272, 6272, 2048, (bf16_t*)(we + WE_IN), 100, 1, nullptr, tile);
        convert_job(wv, INF(I_EV_GLUW) + (size_t)lp * 1024 * 1024, 1024, 1024, (bf16_t*)(we + WE_GLU), 16, 0, nullptr, tile);
        convert_job(wv, INF(I_EV_WOUT) + (size_t)lp * 2048 * 2048, 2048, 2048, (bf16_t*)(we + WE_OUT), 32, 0, nullptr, tile);
        convert_job(wv, INF(I_OD_WIN) + (size_t)lp * 2048 * 3136, 3136, 2048, (bf16_t*)(wo + WO_IN), 52, 2, nullptr, tile);
        convert_job(wv, INF(I_OD_WQ) + (size_t)lp * 512 * 3072, 3072, 512, (bf16_t*)(wo + WO_Q), 48, 3, INF(I_OD_QN) + lp * 512, tile);
        convert_job(wv, INF(I_OD_WKV) + (size_t)lp * 512 * 4096, 4096, 512, (bf16_t*)(wo + WO_K), 32, 4, INF(I_OD_KVN) + lp * 512, tile);
        convert_job(wv, INF(I_OD_WKV) + (size_t)lp * 512 * 4096, 4096, 512, (bf16_t*)(wo + WO_V), 32, 5, INF(I_OD_KVN) + lp * 512, tile);
        convert_job(wv, INF(I_OD_WOUT) + (size_t)lp * 2048 * 2048, 2048, 2048, (bf16_t*)(wo + WO_OUT), 32, 0, nullptr, tile);
    }
    (void)wbf;
    {
        __syncthreads();
        LAS float* sc = (LAS float*)lds;
        LAS float* red = sc + 8192;
        const int tid = launder_tid(wv);
        for (int i = tid; i < 8192; i += 512) sc[i] = fsilu(INF(I_C)[i]);
        __syncthreads();
        float* mod = (float*)(P.ws + OFF_MOD);
        const int col = tid & 63, kg = tid >> 6;
        for (int item = blockIdx.x; item < 4 * 96; item += gridDim.x) {
            const int l = item / 96, j0 = (item % 96) * 64;
            const float* W = ((l & 1) ? INF(I_OD_ADA_W) : INF(I_EV_ADA_W)) + (size_t)(l >> 1) * 2048 * 6144;
            const float* Bv = ((l & 1) ? INF(I_OD_ADA_B) : INF(I_EV_ADA_B)) + (size_t)(l >> 1) * 6144;
            float a0 = 0.f, a1 = 0.f, a2 = 0.f, a3 = 0.f;
#pragma unroll 8
            for (int kk = 0; kk < 256; ++kk) {
                const int k = kg * 256 + kk;
                const float w = W[(size_t)k * 6144 + j0 + col];
                a0 += sc[k] * w; a1 += sc[2048 + k] * w; a2 += sc[4096 + k] * w; a3 += sc[6144 + k] * w;
            }
            red[(kg * 4 + 0) * 64 + col] = a0; red[(kg * 4 + 1) * 64 + col] = a1; red[(kg * 4 + 2) * 64 + col] = a2; red[(kg * 4 + 3) * 64 + col] = a3;
            __syncthreads();
            if (tid < 256) {
                const int b = tid >> 6;
                float s = 0.f;
#pragma unroll
                for (int g = 0; g < 8; ++g) s += red[(g * 4 + b) * 64 + col];
                mod[((size_t)l * 4 + b) * 6144 + j0 + col] = s + Bv[j0 + col];
            }
            __syncthreads();
        }
    }
    {
        float* tab = (float*)(P.ws + OFF_TAB);
        const int* pos = (const int*)P.in[I_POS];
        for (int idx = blockIdx.x * 512 + launder_tid(wv); idx < T_TOK * 32; idx += gridDim.x * 512) {
            const int t = idx >> 5, i = idx & 31;
            const float arg = (float)(-(double)(2 * i) / 64.0 * 13.287712379549449);
            const float inv = ex2(arg);
            const float ang = (float)pos[t] * inv;
            const double rev = (double)ang * 0.15915494309189535;
            const float fr = (float)(rev - floor(rev));
            tab[(size_t)idx * 2] = __builtin_amdgcn_cosf(fr);
            tab[(size_t)idx * 2 + 1] = __builtin_amdgcn_sinf(fr);
        }
    }
}

__device__ __forceinline__ void phase_resnorm(const int wv, const Params& P, const float* hsrc, const bf16_t* y, const float* post, const float* modcur, const float* pre, const float* modnext, bf16_t* zdst, float* hdst) {
    const int tid_ = launder_tid(wv); const int wave = wv, lane = tid_ & 63;
    for (int tok = blockIdx.x * 8 + wave; tok < T_TOK; tok += gridDim.x * 8) {
        const int b = tok >> 12;
        f32x4 hv[8];
#pragma unroll
        for (int i = 0; i < 8; ++i) hv[i] = *(const f32x4*)(hsrc + (size_t)tok * 2048 + i * 256 + lane * 4);
        if (y) {
            f32x4 yv[8]; float ss = 0.f;
#pragma unroll
            for (int i = 0; i < 8; ++i) { const u32x2 yw = *(const u32x2*)(y + (size_t)tok * 2048 + i * 256 + lane * 4); yv[i] = (f32x4){__uint_as_float(yw[0] << 16), __uint_as_float(yw[0] & 0xffff0000u), __uint_as_float(yw[1] << 16), __uint_as_float(yw[1] & 0xffff0000u)}; ss += yv[i][0] * yv[i][0] + yv[i][1] * yv[i][1] + yv[i][2] * yv[i][2] + yv[i][3] * yv[i][3]; }
            ss = wave_sum(ss);
            const float rs = rsqrtf(ss * (1.0f / 2048.0f) + NORM_EPS);
#pragma unroll
            for (int i = 0; i < 8; ++i) {
                const int c = i * 256 + lane * 4;
                const f32x4 g = *(const f32x4*)(modcur + (size_t)b * 6144 + 4096 + c), po = *(const f32x4*)(post + c);
                hv[i] += g * (yv[i] * rs) * po;
                *(f32x4*)(hdst + (size_t)tok * 2048 + c) = hv[i];
            }
        }
        if (zdst) {
            float ss = 0.f;
#pragma unroll
            for (int i = 0; i < 8; ++i) ss += hv[i][0] * hv[i][0] + hv[i][1] * hv[i][1] + hv[i][2] * hv[i][2] + hv[i][3] * hv[i][3];
            ss = wave_sum(ss);
            const float rs = rsqrtf(ss * (1.0f / 2048.0f) + NORM_EPS);
#pragma unroll
            for (int i = 0; i < 8; ++i) {
                const int c = i * 256 + lane * 4;
                const f32x4 pr = *(const f32x4*)(pre + c), sh = *(const f32x4*)(modnext + (size_t)b * 6144 + c), sc = *(const f32x4*)(modnext + (size_t)b * 6144 + 2048 + c);
                const f32x4 z = hv[i] * rs * pr * (sc + 1.0f) + sh;
                u32x2 w = {cvt_pk_bf16(z[0], z[1]), cvt_pk_bf16(z[2], z[3])};
                *(u32x2*)(zdst + (size_t)tok * 2048 + c) = w;
            }
        }
    }
}

__device__ __forceinline__ void phase_da(const int wv, const Params& P, int le) {
    const int tid = launder_tid(wv), lane = tid & 63, c = lane & 15, gq = lane >> 4;
    const bf16_t* pE = (const bf16_t*)(P.ws + OFF_P);
    bf16_t* SG = (bf16_t*)(P.ws + OFF_ZM);
    bf16_t* AV = SG + (size_t)T_TOK * 1024;
    const float* mu = INF(I_EV_MU) + le * 4224 + 4096;
    const int gw = blockIdx.x * 8 + wv, nwav = gridDim.x * 8;
    const int h = gw & 15;
    bf16x8 Bw[4][2], Ba[4][2];
    float w0c[4], a0c[4];
    {
        const float* w2 = INF(I_EV_W2) + (size_t)le * 64 * 1024;
        const float* a2 = INF(I_EV_A2) + (size_t)le * 64 * 1024;
#pragma unroll
        for (int nb = 0; nb < 4; ++nb) {
            const int n = h * 64 + 16 * nb + c;
            w0c[nb] = INF(I_EV_W0)[le * 1024 + n]; a0c[nb] = INF(I_EV_A0)[le * 1024 + n];
#pragma unroll
            for (int ks = 0; ks < 2; ++ks) {
                f32x4 w0v, w1v, a0v, a1v;
#pragma unroll
                for (int i = 0; i < 4; ++i) {
                    const int k = 32 * ks + 8 * gq + i;
                    w0v[i] = w2[(size_t)k * 1024 + n]; w1v[i] = w2[(size_t)(k + 4) * 1024 + n];
                    a0v[i] = a2[(size_t)k * 1024 + n]; a1v[i] = a2[(size_t)(k + 4) * 1024 + n];
                }
                Bw[nb][ks] = pack8(w0v, w1v); Ba[nb][ks] = pack8(a0v, a1v);
            }
        }
    }
    f32x4 mul[2][2][2];
#pragma unroll
    for (int which = 0; which < 2; ++which)
#pragma unroll
        for (int ks = 0; ks < 2; ++ks) { mul[which][ks][0] = *(const f32x4*)(mu + 64 * which + 32 * ks + 8 * gq); mul[which][ks][1] = *(const f32x4*)(mu + 64 * which + 32 * ks + 8 * gq + 4); }
    for (int tb = gw >> 4; tb < T_TOK / 16; tb += (nwav >> 4)) {
        const int tok = tb * 16 + c;
        const bool hasprev = (tok & (SEQ - 1)) != 0;
        bf16x8 Aw[2], Aa[2];
#pragma unroll
        for (int which = 0; which < 2; ++which)
#pragma unroll
            for (int ks = 0; ks < 2; ++ks) {
                const int col = 6144 + 64 * which + 32 * ks + 8 * gq;
                float cu[8], pv[8];
                unpack8(*(const u32x4*)(pE + (size_t)tok * PE_LD + col), cu);
                const u32x4 pw = *(const u32x4*)(pE + (size_t)(tok > 0 ? tok - 1 : 0) * PE_LD + col);
                unpack8(hasprev ? pw : (u32x4){0u, 0u, 0u, 0u}, pv);
                f32x4 x0, x1;
#pragma unroll
                for (int i = 0; i < 4; ++i) { x0[i] = cu[i] + (pv[i] - cu[i]) * mul[which][ks][0][i]; x1[i] = cu[4 + i] + (pv[4 + i] - cu[4 + i]) * mul[which][ks][1][i]; }
                if (which == 0) {
#pragma unroll
                    for (int i = 0; i < 4; ++i) { x0[i] = ftanh(x0[i]); x1[i] = ftanh(x1[i]); }
                    Aw[ks] = pack8(x0, x1);
                } else Aa[ks] = pack8(x0, x1);
            }
#pragma unroll
        for (int nb = 0; nb < 4; ++nb) {
            f32x4 wacc = {0.f, 0.f, 0.f, 0.f}, aacc = {0.f, 0.f, 0.f, 0.f};
            wacc = MFMA16(Aw[0], Bw[nb][0], wacc); wacc = MFMA16(Aw[1], Bw[nb][1], wacc);
            aacc = MFMA16(Aa[0], Ba[nb][0], aacc); aacc = MFMA16(Aa[1], Ba[nb][1], aacc);
            const size_t o_ = ((((size_t)tb * 16 + h) * 4 + nb) * 64 + lane) * 4;
            u32x2 sw = {cvt_pk_bf16(fsigmoid(w0c[nb] + wacc[0]), fsigmoid(w0c[nb] + wacc[1])), cvt_pk_bf16(fsigmoid(w0c[nb] + wacc[2]), fsigmoid(w0c[nb] + wacc[3]))};
            u32x2 aw = {cvt_pk_bf16(fsigmoid(a0c[nb] + aacc[0]), fsigmoid(a0c[nb] + aacc[1])), cvt_pk_bf16(fsigmoid(a0c[nb] + aacc[2]), fsigmoid(a0c[nb] + aacc[3]))};
            *(u32x2*)(SG + o_) = sw; *(u32x2*)(AV + o_) = aw;
        }
    }
}

__device__ __forceinline__ void phase_scan(const int wv, const Params& P, int le, LAS unsigned char* lds) {
    const int wave = wv;
    constexpr unsigned L_BUF = 0, BUF_SZ = 40960, A_SZ = 8192;
    constexpr unsigned L_VV = 81920, VV_SZ = 2048;
    constexpr unsigned L_YB = 86016;
    constexpr unsigned L_BU = 88064, BU_SZ = 8448;
    constexpr unsigned L_XS = 104960, XS_SZ = 4352;
    constexpr unsigned L_ENDS = 113664;
    constexpr unsigned L_COEF = 115712;
    constexpr unsigned L_LORA = 116224;
    constexpr unsigned L_CT = 132608;
    const bf16_t* pE = (const bf16_t*)(P.ws + OFF_P);
    bf16_t* ygelu = (bf16_t*)(P.ws + OFF_KV);
    float* yraw = (float*)(P.ws + OFF_KV + (size_t)T_TOK * 1024 * 2);
    float* bonus = (float*)(P.ws + OFF_BONUS);
    const float* mu = INF(I_EV_MU) + le * 4224;
    constexpr int NCH = 128;

    for (int item = blockIdx.x; item < 256; item += gridDim.x) {
        const int ritem = ((((item & 7) * 8) + ((item >> 3) >> 2)) << 2) | ((item >> 3) & 3);
        const int b = ritem >> 6, h = (ritem >> 2) & 15, vq = ritem & 3, g5 = ritem & 63;
        __syncthreads();
        if (wave < 4) {
            const int tid = launder_tid(wv), lane = tid & 63, c = lane & 15, gq = lane >> 4;
            if (wave == 1) {
                LAS float* CT = (LAS float*)(lds + L_CT);
                const int chn = h * 64 + lane;
                CT[lane] = INF(I_EV_W0)[le * 1024 + chn]; CT[64 + lane] = INF(I_EV_A0)[le * 1024 + chn]; CT[128 + lane] = INF(I_EV_KK)[le * 1024 + chn];
                CT[192 + lane] = INF(I_EV_KA)[le * 1024 + chn]; CT[256 + lane] = INF(I_EV_RK)[le * 1024 + chn]; CT[320 + lane] = mu[chn]; CT[384 + lane] = mu[1024 + chn];
                CT[448 + lane] = mu[4096 + lane]; CT[512 + lane] = mu[4096 + 64 + lane];
                if (lane < 16) CT[576 + lane] = mu[2048 + h * 64 + 16 * vq + lane];
            }
            __syncthreads();
            f32x2 Sa = {0.f, 0.f}, Sb = {0.f, 0.f};
            const int w = wave, lv = 4 * w + gq, ks = c;
            for (int it = 0; it <= NCH; ++it) {
                if (it >= 1) {
                    const int ch = it - 1, buf = ch & 1;
                    const LAS float* pB = (const LAS float*)(lds + launder_u(L_BUF + buf * BUF_SZ + 16 * ks));
                    const LAS float* pV = (const LAS float*)(lds + launder_u(L_VV + buf * VV_SZ + 4 * lv));
                    LAS float* pY = (LAS float*)(lds + launder_u((w < 2 ? 116224u + (unsigned)w * 8192u : 135168u + (unsigned)(w - 2) * 8192u) + (unsigned)lane * 4u));
#define SC_LOAD(X, t_) do { X##r = *(const LAS f32x4*)(pB + (t_) * 64); X##kq = *(const LAS f32x4*)(pB + 2048 + (t_) * 64); X##dec = *(const LAS f32x4*)(pB + 4096 + (t_) * 64); \
                        X##rem = *(const LAS f32x4*)(pB + 6144 + (t_) * 64); X##rep = *(const LAS f32x4*)(pB + 8192 + (t_) * 64); X##v = pV[(t_) * 16]; } while (0)
#define SC_STEP(X, t_) do { \
                        f32x2 p_ = Sa * (f32x2){X##rem[0], X##rem[1]}; p_ = __builtin_elementwise_fma(Sb, (f32x2){X##rem[2], X##rem[3]}, p_); \
                        const float sa_ = row16_sum(p_[0] + p_[1]); \
                        f32x2 ta_ = (f32x2){X##kq[0], X##kq[1]} * X##v; ta_ = __builtin_elementwise_fma(Sa, (f32x2){X##dec[0], X##dec[1]}, ta_); \
                        f32x2 tb_ = (f32x2){X##kq[2], X##kq[3]} * X##v; tb_ = __builtin_elementwise_fma(Sb, (f32x2){X##dec[2], X##dec[3]}, tb_); \
                        Sa = __builtin_elementwise_fma((f32x2){X##rep[0], X##rep[1]}, (f32x2){sa_, sa_}, ta_); Sb = __builtin_elementwise_fma((f32x2){X##rep[2], X##rep[3]}, (f32x2){sa_, sa_}, tb_); \
                        f32x2 q_ = Sa * (f32x2){X##r[0], X##r[1]}; q_ = __builtin_elementwise_fma(Sb, (f32x2){X##r[2], X##r[3]}, q_); \
                        const float yp_ = q_[0] + q_[1]; \
                        if ((t_) + 2 < 32) SC_LOAD(X, (t_) + 2); \
                        pY[(t_) * 64] = yp_; } while (0)
#ifdef PROBE_SCAN2
                    const f32x2 Sa_save = Sa, Sb_save = Sb;
#pragma unroll 1
                    for (int rep_ = 0; rep_ < PROBE_SCAN2; ++rep_) {
                    Sa = Sa_save; Sb = Sb_save;
#else
                    {
#endif
                    f32x4 Ar, Akq, Adec, Arem, Arep, Br, Bkq, Bdec, Brem, Brep; float Av, Bv;
                    SC_LOAD(A, 0); SC_LOAD(B, 1);
#pragma unroll
                    for (int t = 0; t < 32; t += 2) { SC_STEP(A, t); SC_STEP(B, t + 1); }
                    }
#undef SC_LOAD
#undef SC_STEP
                    WAVE_SYNC();
                    {
                        const LAS float* yb = (const LAS float*)(lds + launder_u((w < 2 ? 116224u + (unsigned)w * 8192u : 135168u + (unsigned)(w - 2) * 8192u) + (unsigned)((lane >> 2) * 256 + (lane & 3) * 64)));
#pragma unroll
                        for (int hh = 0; hh < 2; ++hh) {
                            const f32x4 a0 = *(const LAS f32x4*)(yb + hh * 1024), a1 = *(const LAS f32x4*)(yb + hh * 1024 + 4), a2 = *(const LAS f32x4*)(yb + hh * 1024 + 8), a3 = *(const LAS f32x4*)(yb + hh * 1024 + 12);
                            const f32x4 sm = (a0 + a1) + (a2 + a3);
                            const float yv = (sm[0] + sm[1]) + (sm[2] + sm[3]);
                            yraw[(size_t)(b * SEQ + ch * 32 + (lane >> 2) + 16 * hh) * 1024 + h * 64 + 16 * vq + 4 * w + (lane & 3)] = yv;
                        }
                    }
                    WAVE_SYNC();
                }
                __syncthreads();
            }
        } else if (wave < 6) {
            __syncthreads();
            const int tid = launder_tid(wv), lane = tid & 63, c = lane & 15, gq = lane >> 4;
            const int m = wave - 4;
            const unsigned voff_rk = (unsigned)((4 * gq * PE_LD + c) * 2);
            const bf16_t* SGp = (const bf16_t*)(P.ws + OFF_ZM) + (size_t)h * 1024 + lane * 4;
            const bf16_t* AVp = SGp + (size_t)T_TOK * 1024;
            u32x2 sgraw[4], avraw[4];
            unsigned short rraw[4][5], kraw[4][5], vraw[5];
#define PL_TOKBASE(pc_) (b * SEQ + ((pc_) < NCH - 1 ? (pc_) : NCH - 1) * 32 + 16 * m)
#define PREP_LOAD_DA(pc_, nb) do { const size_t to_ = (size_t)(PL_TOKBASE(pc_) >> 4) * 16384 + (nb) * 256; \
            sgraw[nb] = *(const u32x2*)(SGp + to_); avraw[nb] = *(const u32x2*)(AVp + to_); } while (0)
#define PREP_LOAD_RK(pc_, nb) do { const int tokbase_ = PL_TOKBASE(pc_); const int lseq0_ = (tokbase_ - b * SEQ) + 4 * gq; \
            _Pragma("unroll") for (int jj = 0; jj < 5; ++jj) { const bool valid = (jj > 0) || (lseq0_ > 0); \
                const char* ub_ = (const char*)(pE + (size_t)(tokbase_ + jj - 1) * PE_LD + h * 64); \
                const unsigned short r_ = *(const unsigned short*)(ub_ + voff_rk + 32 * (nb)), k_ = *(const unsigned short*)(ub_ + voff_rk + 2048 + 32 * (nb)); \
                rraw[nb][jj] = valid ? r_ : (unsigned short)0; kraw[nb][jj] = valid ? k_ : (unsigned short)0; } } while (0)
#define PREP_LOAD_V(pc_) do { const int tokbase_ = PL_TOKBASE(pc_); const int lseq0_ = (tokbase_ - b * SEQ) + 4 * gq; \
            _Pragma("unroll") for (int jj = 0; jj < 5; ++jj) { const bool valid = (jj > 0) || (lseq0_ > 0); \
                const char* ubv_ = (const char*)(pE + (size_t)(tokbase_ + jj - 1) * PE_LD + h * 64 + 2048 + 16 * vq); \
                const unsigned short v_ = *(const unsigned short*)(ubv_ + voff_rk); vraw[jj] = valid ? v_ : (unsigned short)0; } } while (0)
            PREP_LOAD_DA(0, 0); PREP_LOAD_DA(0, 1); PREP_LOAD_DA(0, 2); PREP_LOAD_DA(0, 3); PREP_LOAD_RK(0, 0); PREP_LOAD_RK(0, 1); PREP_LOAD_RK(0, 2); PREP_LOAD_RK(0, 3); PREP_LOAD_V(0);
            for (int it = 0; it <= NCH; ++it) {
                if (it < NCH) {
                    const int ch = it, buf = ch & 1;
                    const int tok4 = b * SEQ + ch * 32 + 16 * m + 4 * gq;
                    LAS float* wb = (LAS float*)(lds + launder_u(L_BUF + buf * BUF_SZ + ((16 * m + 4 * gq) * 64 + c) * 4));
                    LAS float* wbV = (LAS float*)(lds + launder_u(L_VV + buf * VV_SZ + ((16 * m + 4 * gq) * 16 + c) * 4));
                    const LAS float* ct = (const LAS float*)(lds + launder_u(L_CT + c * 4));
#ifdef PROBE_PREP2
#pragma unroll 1
                    for (int rep_ = 0; rep_ < PROBE_PREP2; ++rep_) {
                    const bool lastrep_ = (rep_ == PROBE_PREP2 - 1);
#else
                    {
                    const bool lastrep_ = true;
#endif
                    float ssq[4] = {0.f, 0.f, 0.f, 0.f}, bon[4] = {0.f, 0.f, 0.f, 0.f};
                    float kkv[4][4], avv[4][4];
#pragma unroll
                    for (int nb = 0; nb < 4; ++nb) {
                        const float kkc = ct[128 + 16 * nb], kac = ct[192 + 16 * nb], rkc = ct[256 + 16 * nb], mur = ct[320 + 16 * nb], muk = ct[384 + 16 * nb];
                        float rp[4], kp[4];
#pragma unroll
                        for (int j = 0; j < 4; ++j) {
                            const float r0 = bf2f(rraw[nb][j]), r1 = bf2f(rraw[nb][j + 1]), k0 = bf2f(kraw[nb][j]), k1 = bf2f(kraw[nb][j + 1]);
                            rp[j] = r1 + (r0 - r1) * mur; kp[j] = k1 + (k0 - k1) * muk;
                        }
                        if (lastrep_) PREP_LOAD_RK(ch + 1, nb);
                        float sgf[4], avf[4];
#pragma unroll
                        for (int j = 0; j < 4; ++j) { const unsigned sw_ = sgraw[nb][j >> 1], aw_ = avraw[nb][j >> 1]; sgf[j] = (j & 1) ? __uint_as_float(sw_ & 0xffff0000u) : __uint_as_float(sw_ << 16); avf[j] = (j & 1) ? __uint_as_float(aw_ & 0xffff0000u) : __uint_as_float(aw_ << 16); }
                        if (lastrep_) PREP_LOAD_DA(ch + 1, nb);
#pragma unroll
                        for (int j = 0; j < 4; ++j) {
                            const float dec = ex2(sgf[j] * (-0.6065306597126334f * 1.4426950408889634f));
                            const float av = avf[j];
                            const float kk = kp[j] * kkc, k2 = kp[j] * (1.0f + (av - 1.0f) * kac);
                            ssq[j] += kk * kk; bon[j] += rp[j] * k2 * rkc;
                            const int lo = j * 64 + 16 * nb;
                            wb[lo] = rp[j]; wb[2048 + lo] = k2; wb[4096 + lo] = dec; kkv[nb][j] = kk; avv[nb][j] = av;
                        }
                        __builtin_amdgcn_sched_barrier(0);
                    }
#pragma unroll
                    for (int j = 0; j < 4; ++j) {
                        const float tot = row16_sum(ssq[j]);
                        const float inv = rsqrtf(fmaxf(tot, 1e-24f));
                        const float bt = row16_sum(bon[j]);
                        if (vq == 0 && c == 0) bonus[(size_t)(tok4 + j) * 16 + h] = bt;
#pragma unroll
                        for (int nb = 0; nb < 4; ++nb) {
                            const int lo = j * 64 + 16 * nb;
                            const float kn = kkv[nb][j] * inv;
                            wb[6144 + lo] = -kn; wb[8192 + lo] = kn * avv[nb][j];
                        }
                    }
                    const float muv = ct[576];
#pragma unroll
                    for (int j = 0; j < 4; ++j) { const float v0 = bf2f(vraw[j]), v1 = bf2f(vraw[j + 1]); wbV[j * 16] = v1 + (v0 - v1) * muv; }
                    if (lastrep_) PREP_LOAD_V(ch + 1);
                    }
                }
                __syncthreads();
            }
#undef PREP_LOAD_DA
#undef PREP_LOAD_RK
#undef PREP_LOAD_V
#undef PL_TOKBASE
        } else {
            const int ws = wave - 6;
            bf16x8 Bbb[8], Bc[4];
            float e_re = 0.f, e_im = 0.f, E16r = 0.f, E16i = 0.f, X0r = 0.f, X0i = 0.f, dval = 0.f;
            {
                const int tid = launder_tid(wv), lane = tid & 63, c = lane & 15, n = lane;
                const float dt = fexp(INF(I_EV_LOGDT)[le * 64 + g5]);
                const float lr = INF(I_EV_LRE)[(le * 64 + g5) * 64 + n], li = INF(I_EV_LIM)[(le * 64 + g5) * 64 + n];
                const float mag = fexp(lr * dt), ang = li * dt;
                const double rev = (double)ang * 0.15915494309189535;
                const float fr = (float)(rev - floor(rev));
                e_re = mag * __builtin_amdgcn_cosf(fr); e_im = mag * __builtin_amdgcn_sinf(fr);
                const float den = lr * lr + li * li;
                const float cr = ((e_re - 1.0f) * lr + e_im * li) / den, ci = (e_im * lr - (e_re - 1.0f) * li) / den;
                if (ws == 0) { LAS float* COEF = (LAS float*)(lds + L_COEF); COEF[n] = cr; COEF[64 + n] = ci; }
                float pr = e_re, pi = e_im;
#pragma unroll
                for (int s = 0; s < 4; ++s) { const float nr = pr * pr - pi * pi, ni = 2.0f * pr * pi; pr = nr; pi = ni; }
                E16r = pr; E16i = pi;
                dval = INF(I_EV_D)[le * 1024 + g5 * 16 + c];
            }
            __syncthreads();
            {
                const int tid2 = launder_tid(wv), c = tid2 & 15, gq = (tid2 >> 4) & 3;
                const LAS float* COEF = (const LAS float*)(lds + L_COEF);
                const float* bre = INF(I_EV_BRE) + (size_t)(le * 64 + g5) * 64 * 16;
                const float* bim = INF(I_EV_BIM) + (size_t)(le * 64 + g5) * 64 * 16;
#pragma unroll
                for (int nb = 0; nb < 8; ++nb) {
                    const int n = 16 * (nb & 3) + c;
                    const float cr = COEF[n], ci = COEF[64 + n];
                    f32x4 v0 = {0.f, 0.f, 0.f, 0.f}, v1 = {0.f, 0.f, 0.f, 0.f};
                    if (gq < 2) {
                        const f32x4 r0 = *(const f32x4*)(bre + n * 16 + 8 * gq), r1 = *(const f32x4*)(bre + n * 16 + 8 * gq + 4);
                        const f32x4 i0 = *(const f32x4*)(bim + n * 16 + 8 * gq), i1 = *(const f32x4*)(bim + n * 16 + 8 * gq + 4);
                        if (nb < 4) { v0 = r0 * cr - i0 * ci; v1 = r1 * cr - i1 * ci; } else { v0 = i0 * cr + r0 * ci; v1 = i1 * cr + r1 * ci; }
                    }
                    Bbb[nb] = pack8(v0, v1);
                    __builtin_amdgcn_sched_barrier(0);
                }
                const float* cre = INF(I_EV_CRE) + (size_t)((le * 64 + g5) * 16 + c) * 64;
                const float* cim = INF(I_EV_CIM) + (size_t)((le * 64 + g5) * 16 + c) * 64;
#pragma unroll
                for (int ks = 0; ks < 4; ++ks) {
                    const int nn = 32 * ks + 8 * gq;
                    f32x4 v0, v1;
                    if (ks < 2) { v0 = *(const f32x4*)(cre + nn); v1 = *(const f32x4*)(cre + nn + 4); }
                    else { v0 = -*(const f32x4*)(cim + nn - 64); v1 = -*(const f32x4*)(cim + nn - 64 + 4); }
                    Bc[ks] = pack8(v0, v1);
                    __builtin_amdgcn_sched_barrier(0);
                }
            }
            {
                const int tid3 = launder_tid(wv), lane = tid3 & 63, c = lane & 15, gq = lane >> 4, n = lane;
                LAS float* bu = (LAS float*)(lds + launder_u(L_BU + ws * BU_SZ + n * 4));
                LAS float* buw = (LAS float*)(lds + launder_u(L_BU + ws * BU_SZ + ((4 * gq) * 132 + c) * 4));
                LAS bf16_t* xsw = (LAS bf16_t*)(lds + launder_u(L_XS + ws * XS_SZ + n * 2));
                const LAS bf16_t* xs = (const LAS bf16_t*)(lds + launder_u(L_XS + ws * XS_SZ + (c * 136 + 8 * gq) * 2));
                LAS float* ends = (LAS float*)(lds + launder_u(L_ENDS + n * 4));
                bf16x8 Acur = {0, 0, 0, 0, 0, 0, 0, 0};
                if (gq < 2) Acur = *(const bf16x8*)(pE + (size_t)(b * SEQ + 16 * ws + c) * PE_LD + 4096 + g5 * 16 + 8 * gq);
                unsigned short ucur[4], uprev[4] = {0, 0, 0, 0};
#pragma unroll
                for (int j = 0; j < 4; ++j) ucur[j] = pE[(size_t)(b * SEQ + 16 * ws + 4 * gq + j) * PE_LD + 4096 + g5 * 16 + c];
                for (int it = 0; it <= NCH; ++it) {
                    if (it >= 1) {
                        const int ch = it - 1, par = ch & 1;
                        const int tok0 = b * SEQ + ch * 32 + 16 * ws;
                        float cr = X0r, ci = X0i, cinr = 0.f, cini = 0.f;
#pragma unroll
                        for (int s = 0; s < 2; ++s) {
                            if (s == ws) { cinr = cr; cini = ci; }
                            const float er = ends[(par * 2 + s) * 128], ei = ends[(par * 2 + s) * 128 + 64];
                            const float nr = E16r * cr - E16i * ci + er, ni = E16r * ci + E16i * cr + ei;
                            cr = nr; ci = ni;
                        }
                        X0r = cr; X0i = ci;
                        float xr = cinr, xi = cini;
#pragma unroll
                        for (int i = 0; i < 16; ++i) {
                            const float br = bu[i * 132], bi = bu[i * 132 + 64];
                            const float nr = e_re * xr - e_im * xi + br, ni = e_re * xi + e_im * xr + bi;
                            xr = nr; xi = ni;
                            xsw[i * 136] = f2bf(xr); xsw[i * 136 + 64] = f2bf(xi);
                        }
                        WAVE_SYNC();
                        f32x4 acc = {0.f, 0.f, 0.f, 0.f};
#pragma unroll
                        for (int ks = 0; ks < 4; ++ks) {
                            const bf16x8 A = *(const LAS bf16x8*)(xs + 32 * ks);
                            acc = MFMA16(A, Bc[ks], acc);
                        }
#pragma unroll
                        for (int j = 0; j < 4; ++j) {
                            const size_t tok = (size_t)(tok0 + 4 * gq + j);
                            ygelu[tok * 1024 + g5 * 16 + c] = f2bf(fgelu(acc[j] + dval * bf2f(uprev[j])));
                        }
                        WAVE_SYNC();
                    }
                    if (it < NCH) {
                        const int ch = it, par = ch & 1;
#pragma unroll
                        for (int nb = 0; nb < 8; ++nb) {
                            f32x4 acc = {0.f, 0.f, 0.f, 0.f};
                            acc = MFMA16(Acur, Bbb[nb], acc);
#pragma unroll
                            for (int j = 0; j < 4; ++j) buw[j * 132 + 16 * nb] = acc[j];
                        }
#pragma unroll
                        for (int j = 0; j < 4; ++j) uprev[j] = ucur[j];
                        {
                            const int nc = it + 1 < NCH ? it + 1 : NCH - 1;
                            const int tokn = b * SEQ + nc * 32 + 16 * ws;
                            if (gq < 2) Acur = *(const bf16x8*)(pE + (size_t)(tokn + c) * PE_LD + 4096 + g5 * 16 + 8 * gq);
#pragma unroll
                            for (int j = 0; j < 4; ++j) ucur[j] = pE[(size_t)(tokn + 4 * gq + j) * PE_LD + 4096 + g5 * 16 + c];
                        }
                        WAVE_SYNC();
                        float xr = 0.f, xi = 0.f;
#pragma unroll
                        for (int i = 0; i < 16; ++i) {
                            const float br = bu[i * 132], bi = bu[i * 132 + 64];
                            const float nr = e_re * xr - e_im * xi + br, ni = e_re * xi + e_im * xr + bi;
                            xr = nr; xi = ni;
                        }
                        ends[(par * 2 + ws) * 128] = xr; ends[(par * 2 + ws) * 128 + 64] = xi;
                    }
                    __syncthreads();
                }
            }
        }
    }
}

__device__ __forceinline__ void phase_rwkv_post(const int wv, const Params& P, int le) {
    const int tid_ = launder_tid(wv); const int wave = wv, lane = tid_ & 63;
    const bf16_t* pE = (const bf16_t*)(P.ws + OFF_P);
    const float* yraw = (const float*)(P.ws + OFF_KV + (size_t)T_TOK * 1024 * 2);
    const float* bonus = (const float*)(P.ws + OFF_BONUS);
    bf16_t* mix = (bf16_t*)(P.ws + OFF_ZM);
    const float* mu = INF(I_EV_MU) + le * 4224;
    const int hh = lane >> 4, cs = lane & 15;
#pragma unroll 2
    for (int idx = blockIdx.x * 8 + wave; idx < T_TOK * 4; idx += gridDim.x * 8) {
        const int tok = idx >> 2, h = (idx & 3) * 4 + hh, chn = h * 64 + 4 * cs;
        const bool hasprev = (tok & (SEQ - 1)) != 0;
        const f32x4 yv = *(const f32x4*)(yraw + (size_t)tok * 1024 + chn);
        const u32x2 vcw = *(const u32x2*)(pE + (size_t)tok * PE_LD + 2048 + chn), gcw = *(const u32x2*)(pE + (size_t)tok * PE_LD + 3072 + chn);
        u32x2 vpw = {0u, 0u}, gpw = {0u, 0u};
        if (hasprev) { vpw = *(const u32x2*)(pE + (size_t)(tok - 1) * PE_LD + 2048 + chn); gpw = *(const u32x2*)(pE + (size_t)(tok - 1) * PE_LD + 3072 + chn); }
        const f32x4 muv = *(const f32x4*)(mu + 2048 + chn), mug = *(const f32x4*)(mu + 3072 + chn);
        const f32x4 lg = *(const f32x4*)(INF(I_EV_LNG) + le * 1024 + chn), lb = *(const f32x4*)(INF(I_EV_LNB) + le * 1024 + chn);
        const float bo = bonus[(size_t)tok * 16 + h];
        const float mean = row16_sum(yv[0] + yv[1] + yv[2] + yv[3]) * (1.0f / 64.0f);
        const f32x4 d = yv - mean;
        const float var = row16_sum(d[0] * d[0] + d[1] * d[1] + d[2] * d[2] + d[3] * d[3]) * (1.0f / 64.0f);
        const float rstd = rsqrtf(var + LNX_EPS);
        float vc[4] = {__uint_as_float(vcw[0] << 16), __uint_as_float(vcw[0] & 0xffff0000u), __uint_as_float(vcw[1] << 16), __uint_as_float(vcw[1] & 0xffff0000u)};
        float gc[4] = {__uint_as_float(gcw[0] << 16), __uint_as_float(gcw[0] & 0xffff0000u), __uint_as_float(gcw[1] << 16), __uint_as_float(gcw[1] & 0xffff0000u)};
        float vp[4] = {__uint_as_float(vpw[0] << 16), __uint_as_float(vpw[0] & 0xffff0000u), __uint_as_float(vpw[1] << 16), __uint_as_float(vpw[1] & 0xffff0000u)};
        float gp[4] = {__uint_as_float(gpw[0] << 16), __uint_as_float(gpw[0] & 0xffff0000u), __uint_as_float(gpw[1] << 16), __uint_as_float(gpw[1] & 0xffff0000u)};
        float o[4];
#pragma unroll
        for (int e = 0; e < 4; ++e) {
            const float yn = d[e] * rstd * lg[e] + lb[e];
            const float vs = vc[e] + (vp[e] - vc[e]) * muv[e], gs = gc[e] + (gp[e] - gc[e]) * mug[e];
            o[e] = (yn + bo * vs) * fsilu(gs);
        }
        u32x2 w = {cvt_pk_bf16(o[0], o[1]), cvt_pk_bf16(o[2], o[3])};
        *(u32x2*)(mix + (size_t)tok * 2048 + chn) = w;
    }
}

__device__ __forceinline__ void phase_odd_prep(const int wv, const Params& P) {
    const int tid_ = launder_tid(wv); const int wave = wv, lane = tid_ & 63;
    const bf16_t* pO = (const bf16_t*)(P.ws + OFF_P);
    const float* tab = (const float*)(P.ws + OFF_TAB);
    bf16_t* kpe = (bf16_t*)(P.ws + OFF_KPE);
    float* rsq = (float*)(P.ws + OFF_RSQ);
    float* rskv = (float*)(P.ws + OFF_RSKV);
    for (int tok = blockIdx.x * 8 + wave; tok < T_TOK; tok += gridDim.x * 8) {
        const bf16_t* row = pO + (size_t)tok * PO_LD;
        float a[8], bq[8];
        unpack8(*(const u32x4*)(row + 8 * lane), a);
        unpack8(*(const u32x4*)(row + 512 + 8 * lane), bq);
        float s1 = 0.f, s2 = 0.f;
#pragma unroll
        for (int i = 0; i < 8; ++i) { s1 += a[i] * a[i]; s2 += bq[i] * bq[i]; }
        s1 = wave_sum(s1); s2 = wave_sum(s2);
        if (lane == 0) { rsq[tok] = rsqrtf(s1 * (1.0f / 512.0f) + NORM_EPS); rskv[tok] = rsqrtf(s2 * (1.0f / 512.0f) + NORM_EPS); }
        if (lane < 32) {
            const float t1 = bf2f(row[3072 + lane]), t2 = bf2f(row[3072 + 32 + lane]);
            const f32x2 cs = *(const f32x2*)(tab + ((size_t)tok * 32 + lane) * 2);
            const float o1 = t1 * cs[0] - t2 * cs[1], o2 = t2 * cs[0] + t1 * cs[1];
            *(unsigned*)(kpe + (size_t)tok * 64 + 2 * lane) = cvt_pk_bf16(o1, o2);
        }
    }
}

__device__ __forceinline__ void phase_attn(const int wv, const Params& P, LAS unsigned char* lds) {
    const int wave = wv;
    const bf16_t* q = (const bf16_t*)(P.ws + OFF_Q);
    const bf16_t* kn = (const bf16_t*)(P.ws + OFF_KV);
    const bf16_t* vT = kn + (size_t)T_TOK * 2048;
    const bf16_t* kpe = (const bf16_t*)(P.ws + OFF_KPE);
    const bf16_t* pO = (const bf16_t*)(P.ws + OFF_P);
    bf16_t* mix = (bf16_t*)(P.ws + OFF_ZM);
    constexpr int KB_BYTES = 64 * 400, VB_BYTES = 128 * 144, VB0 = 2 * KB_BYTES;
    for (int it = blockIdx.x; it < 1024; it += gridDim.x) {
        const int tid = launder_tid(wv), lane = tid & 63, c = lane & 15, gq = lane >> 4;
        const int k4 = it >> 8, blk = it & 255, bh = blk & 63, qd = blk >> 6, b = bh >> 4, h = bh & 15;
        const int qb = (k4 == 0) ? 15 - qd : (k4 == 1) ? 11 - qd : (k4 == 2) ? 4 + qd : qd;
        const int q0 = 256 * qb + 32 * wave;
        bf16x8 Qf[2][6];
#pragma unroll
        for (int sb = 0; sb < 2; ++sb)
#pragma unroll
            for (int ks = 0; ks < 6; ++ks) Qf[sb][ks] = *(const bf16x8*)(q + (size_t)(b * SEQ + q0 + 16 * sb + c) * 3072 + h * 192 + 32 * ks + 8 * gq);
        f32x4 o[2][8];
#pragma unroll
        for (int sb = 0; sb < 2; ++sb)
#pragma unroll
            for (int db = 0; db < 8; ++db) o[sb][db] = (f32x4){0.f, 0.f, 0.f, 0.f};
        float mrun[2] = {-1e30f, -1e30f}, lrun[2] = {0.f, 0.f};
        const int ntiles = 4 * qb + 4;
        const int kr0 = tid >> 4, kc0 = tid & 15, pr0 = tid >> 3, pc0 = tid & 7;
        const bf16_t* knb = kn + (size_t)(b * SEQ) * 2048 + h * 128 + kc0 * 8;
        const bf16_t* kpb = kpe + (size_t)(b * SEQ) * 64 + pc0 * 8;
        const bf16_t* vtb = vT + (size_t)(h * 128) * T_TOK + b * SEQ + pc0 * 8;
        u32x4 sk0, sk1, sk2, sv0, sv1;
#define ATT_LOAD(kt) do { const int kbase = 64 * (kt); \
        sk0 = *(const u32x4*)(knb + (size_t)(kbase + kr0) * 2048); sk1 = *(const u32x4*)(knb + (size_t)(kbase + kr0 + 32) * 2048); \
        sk2 = *(const u32x4*)(kpb + (size_t)(kbase + pr0) * 64); \
        sv0 = *(const u32x4*)(vtb + (size_t)pr0 * T_TOK + kbase); sv1 = *(const u32x4*)(vtb + (size_t)(pr0 + 64) * T_TOK + kbase); } while (0)
#define ATT_STORE(buf) do { LAS unsigned char* kd = lds + (buf) * KB_BYTES; LAS unsigned char* vd = lds + VB0 + (buf) * VB_BYTES; \
        *(LAS u32x4*)(kd + kr0 * 400 + kc0 * 16) = sk0; *(LAS u32x4*)(kd + (kr0 + 32) * 400 + kc0 * 16) = sk1; \
        *(LAS u32x4*)(kd + pr0 * 400 + 256 + pc0 * 16) = sk2; \
        *(LAS u32x4*)(vd + pr0 * 144 + pc0 * 16) = sv0; *(LAS u32x4*)(vd + (pr0 + 64) * 144 + pc0 * 16) = sv1; } while (0)
        ATT_LOAD(0);
        ATT_STORE(0);
        __syncthreads();
        for (int kt = 0; kt < ntiles; ++kt) {
            const int buf = kt & 1;
            bool loaded = false;
            if (64 * kt <= q0 + 31) {
                const LAS unsigned char* kd = lds + buf * KB_BYTES;
                const LAS unsigned char* vd = lds + VB0 + buf * VB_BYTES;
                f32x4 s[2][4];
#pragma unroll
                for (int sb = 0; sb < 2; ++sb)
#pragma unroll
                    for (int kb = 0; kb < 4; ++kb) s[sb][kb] = (f32x4){0.f, 0.f, 0.f, 0.f};
                {
                    const LAS unsigned char* kbase = kd + c * 400 + gq * 16;
                    bf16x8 kfA[6], kfB[6];
#pragma unroll
                    for (int ks = 0; ks < 6; ++ks) kfA[ks] = *(const LAS bf16x8*)(kbase + ks * 64);
#pragma unroll
                    for (int ks = 0; ks < 6; ++ks) kfB[ks] = *(const LAS bf16x8*)(kbase + 6400 + ks * 64);
                    __builtin_amdgcn_sched_barrier(0);
#pragma unroll
                    for (int ks = 0; ks < 6; ++ks) { s[0][0] = MFMA16(kfA[ks], Qf[0][ks], s[0][0]); s[1][0] = MFMA16(kfA[ks], Qf[1][ks], s[1][0]); }
                    __builtin_amdgcn_sched_barrier(0);
#pragma unroll
                    for (int ks = 0; ks < 6; ++ks) kfA[ks] = *(const LAS bf16x8*)(kbase + 12800 + ks * 64);
                    __builtin_amdgcn_sched_barrier(0);
#pragma unroll
                    for (int ks = 0; ks < 6; ++ks) { s[0][1] = MFMA16(kfB[ks], Qf[0][ks], s[0][1]); s[1][1] = MFMA16(kfB[ks], Qf[1][ks], s[1][1]); }
                    __builtin_amdgcn_sched_barrier(0);
#pragma unroll
                    for (int ks = 0; ks < 6; ++ks) kfB[ks] = *(const LAS bf16x8*)(kbase + 19200 + ks * 64);
                    __builtin_amdgcn_sched_barrier(0);
#pragma unroll
                    for (int ks = 0; ks < 6; ++ks) { s[0][2] = MFMA16(kfA[ks], Qf[0][ks], s[0][2]); s[1][2] = MFMA16(kfA[ks], Qf[1][ks], s[1][2]); }
                    __builtin_amdgcn_sched_barrier(0);
#pragma unroll
                    for (int ks = 0; ks < 6; ++ks) { s[0][3] = MFMA16(kfB[ks], Qf[0][ks], s[0][3]); s[1][3] = MFMA16(kfB[ks], Qf[1][ks], s[1][3]); }
                    __builtin_amdgcn_sched_barrier(0);
                }
                if (64 * kt + 63 > q0) {
#pragma unroll
                    for (int sb = 0; sb < 2; ++sb)
#pragma unroll
                        for (int kb = 0; kb < 4; ++kb)
#pragma unroll
                            for (int j = 0; j < 4; ++j) { const int key = 64 * kt + 16 * kb + 4 * gq + j, qrow = q0 + 16 * sb + c; if (key > qrow) s[sb][kb][j] = -__builtin_inff(); }
                }
                if (kt + 1 < ntiles) { ATT_LOAD(kt + 1); loaded = true; }
                bf16x8 pf[2][2];
#pragma unroll
                for (int sb = 0; sb < 2; ++sb) {
                    float mx = s[sb][0][0];
#pragma unroll
                    for (int kb = 0; kb < 4; ++kb)
#pragma unroll
                        for (int j = 0; j < 4; ++j) mx = fmaxf(mx, s[sb][kb][j]);
                    mx = xrow_max(mx);
                    const float mnew = fmaxf(mrun[sb], mx);
                    const float alpha = ex2(mrun[sb] - mnew);
                    mrun[sb] = mnew;
                    float psum = 0.f;
#pragma unroll
                    for (int kb = 0; kb < 4; ++kb)
#pragma unroll
                        for (int j = 0; j < 4; ++j) { const float pv = ex2(s[sb][kb][j] - mnew); s[sb][kb][j] = pv; psum += pv; }
                    lrun[sb] = lrun[sb] * alpha + psum;
                    if (__builtin_amdgcn_ballot_w64(alpha != 1.0f) != 0ull) {
#pragma unroll
                        for (int db = 0; db < 8; ++db) o[sb][db] *= alpha;
                    }
                    pf[sb][0] = pack8(s[sb][0], s[sb][1]); pf[sb][1] = pack8(s[sb][2], s[sb][3]);
                }
                {
                    const LAS unsigned char* vbase = vd + c * 144 + gq * 8;
#define VFRAG(db_, ks2_) ({ const u32x2 lo_ = *(const LAS u32x2*)(vbase + (db_) * 2304 + (ks2_) * 64); const u32x2 hi_ = *(const LAS u32x2*)(vbase + (db_) * 2304 + (ks2_) * 64 + 32); \
                            u32x4 w_ = {lo_[0], lo_[1], hi_[0], hi_[1]}; *reinterpret_cast<bf16x8*>(&w_); })
                    bf16x8 vA0 = VFRAG(0, 0), vA1 = VFRAG(0, 1), vB0 = VFRAG(1, 0), vB1 = VFRAG(1, 1);
                    __builtin_amdgcn_sched_barrier(0);
#pragma unroll
                    for (int db = 0; db < 8; db += 2) {
                        o[0][db] = MFMA16(vA0, pf[0][0], o[0][db]); o[1][db] = MFMA16(vA0, pf[1][0], o[1][db]);
                        o[0][db] = MFMA16(vA1, pf[0][1], o[0][db]); o[1][db] = MFMA16(vA1, pf[1][1], o[1][db]);
                        __builtin_amdgcn_sched_barrier(0);
                        if (db + 2 < 8) { vA0 = VFRAG(db + 2, 0); vA1 = VFRAG(db + 2, 1); }
                        __builtin_amdgcn_sched_barrier(0);
                        o[0][db + 1] = MFMA16(vB0, pf[0][0], o[0][db + 1]); o[1][db + 1] = MFMA16(vB0, pf[1][0], o[1][db + 1]);
                        o[0][db + 1] = MFMA16(vB1, pf[0][1], o[0][db + 1]); o[1][db + 1] = MFMA16(vB1, pf[1][1], o[1][db + 1]);
                        __builtin_amdgcn_sched_barrier(0);
                        if (db + 3 < 8) { vB0 = VFRAG(db + 3, 0); vB1 = VFRAG(db + 3, 1); }
                        __builtin_amdgcn_sched_barrier(0);
                    }
#undef VFRAG
                }
            }
            if (kt + 1 < ntiles) { if (!loaded) ATT_LOAD(kt + 1); ATT_STORE(buf ^ 1); }
            __syncthreads();
        }
#undef ATT_LOAD
#undef ATT_STORE
#pragma unroll
        for (int sb = 0; sb < 2; ++sb) {
            const float lt = xrow_sum(lrun[sb]);
            const float inv = 1.0f / lt;
            const size_t tok = (size_t)(b * SEQ + q0 + 16 * sb + c);
#pragma unroll
            for (int db = 0; db < 8; ++db) {
                const int dv0 = 16 * db + 4 * gq;
                const u32x2 gw = *(const u32x2*)(pO + tok * PO_LD + 1024 + h * 128 + dv0);
                const float g0 = __uint_as_float(gw[0] << 16), g1 = __uint_as_float(gw[0] & 0xffff0000u), g2 = __uint_as_float(gw[1] << 16), g3 = __uint_as_float(gw[1] & 0xffff0000u);
                const f32x4 ov = o[sb][db] * inv;
                u32x2 w = {cvt_pk_bf16(ov[0] * fsilu(g0), ov[1] * fsilu(g1)), cvt_pk_bf16(ov[2] * fsilu(g2), ov[3] * fsilu(g3))};
                *(u32x2*)(mix + tok * 2048 + h * 128 + dv0) = w;
            }
        }
    }
}

#define XB_TMO      128
#define XB_XCNT(j)  (256  + 64 * (j))
#define XB_XSUB(j)  (1280 + 64 * (j))
#define XB_XGEN(j)  (2304 + 64 * (j))
#define XB_TOP      3328
#define XB_TOPGEN   3392
#define XCD_BAR_WORDS 3456
#define XB_SPIN_CAP (1u << 18)
__device__ __forceinline__ unsigned xb_ld(unsigned* p)              { return __hip_atomic_load(p, __ATOMIC_RELAXED, __HIP_MEMORY_SCOPE_AGENT); }
__device__ __forceinline__ unsigned xb_add(unsigned* p, unsigned v) { return __hip_atomic_fetch_add(p, v, __ATOMIC_RELAXED, __HIP_MEMORY_SCOPE_AGENT); }
__device__ __forceinline__ unsigned xb_xcc_id() { return (unsigned)__builtin_amdgcn_s_getreg((3 << 11) | 20) & 0xFu; }
#define XB_SPIN(cond, bar) do { unsigned _sp = 0; while (cond) { __builtin_amdgcn_s_sleep(1); \
    if ((++_sp & 255u) == 0u) { if (xb_ld(&(bar)[XB_TMO])) break; if (_sp > XB_SPIN_CAP) { atomicAdd(&(bar)[XB_TMO], 1u); break; } } } } while (0)
struct XcdBarrier { unsigned* bar; unsigned x; volatile LAS unsigned* st; };
__device__ __forceinline__ XcdBarrier xcd_barrier_post(unsigned* bar, volatile LAS unsigned* st) {
    XcdBarrier b; b.bar = bar; b.x = xb_xcc_id(); b.st = st;
    if (threadIdx.x == 0) (void)xb_add(&bar[XB_XCNT(b.x)], 1u);
    return b;
}
__device__ __forceinline__ void xcd_barrier_complete(unsigned* bar, unsigned x, unsigned& nloc, unsigned& nx) {
    const unsigned G = gridDim.x * gridDim.y * gridDim.z;
    unsigned sum, cnt, mine, sp = 0u;
    for (;;) {
        sum = 0u; cnt = 0u; mine = 0u;
#pragma unroll
        for (unsigned j = 0; j < 16; ++j) { const unsigned c = xb_ld(&bar[XB_XCNT(j)]); sum += c; cnt += (c > 0u) ? 1u : 0u; mine = (j == x) ? c : mine; }
        if (sum == G) break;
        __builtin_amdgcn_s_sleep(1);
        if ((++sp & 255u) == 0u) { if (xb_ld(&bar[XB_TMO])) break; if (sp > XB_SPIN_CAP) { atomicAdd(&bar[XB_TMO], 1u); break; } }
    }
    nloc = mine > 0u ? mine : 1u; nx = cnt > 0u ? cnt : 1u;
}
__device__ __forceinline__ void xcd_barrier(const XcdBarrier& b) {
    asm volatile("s_waitcnt vmcnt(0)" ::: "memory");
    __syncthreads();
    if (threadIdx.x == 0) {
        unsigned* bar = b.bar;
        unsigned bx = b.x; asm volatile("" : "+s"(bx));
        __builtin_amdgcn_s_waitcnt(0);
        unsigned nloc = b.st[0], nx = b.st[1];
        if (nloc == 0u) { xcd_barrier_complete(bar, bx, nloc, nx); b.st[0] = nloc; b.st[1] = nx; }
        const unsigned old = xb_add(&bar[XB_XSUB(bx)], 1u);
        const unsigned gen = old / nloc;
        if (old + 1u == (gen + 1u) * nloc) {
            __builtin_amdgcn_fence(__ATOMIC_RELEASE, "agent");
            asm volatile("s_waitcnt vmcnt(0)" ::: "memory");
            const unsigned og = xb_add(&bar[XB_TOP], 1u);
            const unsigned tg = og / nx;
            if (og + 1u == (tg + 1u) * nx) xb_add(&bar[XB_TOPGEN], 1u);
            else XB_SPIN(xb_ld(&bar[XB_TOPGEN]) == tg, bar);
            __builtin_amdgcn_fence(__ATOMIC_ACQUIRE, "agent");
            xb_add(&bar[XB_XGEN(bx)], 1u);
            asm volatile("s_waitcnt vmcnt(0)" ::: "memory");
        } else {
            XB_SPIN(xb_ld(&bar[XB_XGEN(bx)]) == gen, bar);
            __builtin_amdgcn_fence(__ATOMIC_ACQUIRE, "agent");
            asm volatile("s_waitcnt vmcnt(0)" ::: "memory");
        }
    }
    __syncthreads();
}

__global__ void __launch_bounds__(512, 2) fwd_megakernel(Params P) {
    extern __shared__ __attribute__((aligned(16))) unsigned char shm_raw[];
    LAS unsigned char* lds = (LAS unsigned char*)shm_raw;
    cg::grid_group grid = cg::this_grid();
    const int wv = __builtin_amdgcn_readfirstlane((int)threadIdx.x >> 6);
    volatile LAS unsigned* xst = (volatile LAS unsigned*)(lds + (LDS_BYTES - 16));
    if (threadIdx.x == 0) { xst[0] = 0u; xst[1] = 0u; }
    __syncthreads();
    const XcdBarrier xb = xcd_barrier_post((unsigned*)(P.ws + OFF_BAR), xst);
#define GSYNC() xcd_barrier(xb)
    const float* mod = (const float*)(P.ws + OFF_MOD);
    bf16_t* zm = (bf16_t*)(P.ws + OFF_ZM);
    bf16_t* pbuf = (bf16_t*)(P.ws + OFF_P);
    bf16_t* ybuf = (bf16_t*)(P.ws + OFF_P);

    for (int r = 0; r < P.reps[8]; ++r) GSYNC();
    if (P.reps[15] == 0x7fffffff) grid.sync();
    for (int r = 0; r < P.reps[2]; ++r) { phase_prep(wv, P, lds); GSYNC(); }
    phase_resnorm(wv, P, INF(I_X), nullptr, nullptr, nullptr, INF(I_EV_NPRE), mod, zm, nullptr);
    GSYNC();

    for (int layer = 0; layer < 4; ++layer) {
        const int j = layer >> 1;
        unsigned char* we = P.ws + OFF_WBF + (size_t)j * (SZ_WE + SZ_WO);
        unsigned char* wo = we + SZ_WE;
        if ((layer & 1) == 0) {
            for (int r = 0; r < P.reps[3]; ++r) { Epi<EPI_BF16> E{}; E.O = pbuf; E.ldc = PE_LD; run_gemm<EPI_BF16>(wv, lds, zm, 2048, (const bf16_t*)(we + WE_IN), 2048, T_TOK, 6400, 2048, E);
            GSYNC(); }
            phase_da(wv, P, j); GSYNC();
            for (int r = 0; r < P.reps[0]; ++r) { phase_scan(wv, P, j, lds); GSYNC(); }
            for (int r = 0; r < P.reps[7]; ++r) {
            phase_rwkv_post(wv, P, j);
            { Epi<EPI_GLU> E{}; E.O = zm; E.ldc = 2048; E.bias = INF(I_EV_GLUB) + j * 1024; E.yg = (const bf16_t*)(P.ws + OFF_KV); E.pe = pbuf;
              run_gemm<EPI_GLU>(wv, lds, (const bf16_t*)(P.ws + OFF_KV), 1024, (const bf16_t*)(we + WE_GLU), 1024, T_TOK, 1024, 1024, E); }
            GSYNC(); }
            for (int r = 0; r < P.reps[6]; ++r) { Epi<EPI_BF16> E{}; E.O = ybuf; E.ldc = 2048; run_gemm<EPI_BF16>(wv, lds, zm, 2048, (const bf16_t*)(we + WE_OUT), 2048, T_TOK, 2048, 2048, E);
            GSYNC(); }
        } else {
            for (int r = 0; r < P.reps[4]; ++r) { Epi<EPI_BF16> E{}; E.O = pbuf; E.ldc = PO_LD; run_gemm<EPI_BF16>(wv, lds, zm, 2048, (const bf16_t*)(wo + WO_IN), 2048, T_TOK, 3328, 2048, E);
            GSYNC(); }
            phase_odd_prep(wv, P);
            GSYNC();
            for (int r = 0; r < P.reps[5]; ++r) {
            { Epi<EPI_Q> E{}; E.O = P.ws + OFF_Q; E.ldc = 3072; E.rs = (const float*)(P.ws + OFF_RSQ); E.tab = (const float*)(P.ws + OFF_TAB);
              run_gemm<EPI_Q>(wv, lds, pbuf, PO_LD, (const bf16_t*)(wo + WO_Q), 512, T_TOK, 3072, 512, E); }
            { Epi<EPI_KN> E{}; E.O = P.ws + OFF_KV; E.ldc = 2048; E.rs = (const float*)(P.ws + OFF_RSKV);
              run_gemm<EPI_KN>(wv, lds, pbuf + 512, PO_LD, (const bf16_t*)(wo + WO_K), 512, T_TOK, 2048, 512, E); }
            { Epi<EPI_VT> E{}; E.O = P.ws + OFF_KV + (size_t)T_TOK * 2048 * 2; E.ldc = T_TOK; E.rs = (const float*)(P.ws + OFF_RSKV);
              run_gemm<EPI_VT>(wv, lds, (const bf16_t*)(wo + WO_V), 512, pbuf + 512, PO_LD, 2048, T_TOK, 512, E); }
            GSYNC(); }
            for (int r = 0; r < P.reps[1]; ++r) { phase_attn(wv, P, lds); GSYNC(); }
            for (int r = 0; r < P.reps[6]; ++r) { Epi<EPI_BF16> E{}; E.O = ybuf; E.ldc = 2048; run_gemm<EPI_BF16>(wv, lds, zm, 2048, (const bf16_t*)(wo + WO_OUT), 2048, T_TOK, 2048, 2048, E);
            GSYNC(); }
        }
        {
            const float* post = ((layer & 1) ? INF(I_OD_NPOST) : INF(I_EV_NPOST)) + j * 2048;
            const float* hsrc = layer == 0 ? INF(I_X) : P.out;
            const int nl = layer + 1;
            const float* pre = nl < 4 ? (((nl & 1) ? INF(I_OD_NPRE) : INF(I_EV_NPRE)) + (nl >> 1) * 2048) : nullptr;
            phase_resnorm(wv, P, hsrc, ybuf, post, mod + (size_t)layer * 4 * 6144, pre, mod + (size_t)nl * 4 * 6144, nl < 4 ? zm : nullptr, P.out);
        }
        if (layer < 3) GSYNC();
    }
}

extern "C" void kernel_launch(void* const* d_in, const int* in_sizes, int n_in, void* d_out, int out_size, void* d_ws, size_t ws_size, hipStream_t stream) {
    static int grid_blocks = 0;
    if (!grid_blocks) {
        int dev = 0, cus = 0, per_cu = 0;
        (void)hipGetDevice(&dev);
        (void)hipDeviceGetAttribute(&cus, hipDeviceAttributeMultiprocessorCount, dev);
        (void)hipFuncSetAttribute((const void*)fwd_megakernel, hipFuncAttributeMaxDynamicSharedMemorySize, LDS_BYTES);
        (void)hipOccupancyMaxActiveBlocksPerMultiprocessor(&per_cu, fwd_megakernel, 512, LDS_BYTES);
        if (per_cu < 1) per_cu = 1;
        grid_blocks = cus * per_cu;
        if (grid_blocks > 256) grid_blocks = 256;
    }
    if (ws_size < WS_NEED) fprintf(stderr, "workspace too small: %zu < %zu\n", ws_size, (size_t)WS_NEED);
    Params p;
    memset(&p, 0, sizeof(p));
    for (int i = 0; i < n_in && i < 40; ++i) p.in[i] = d_in[i];
    for (int i = 0; i < 16; ++i) p.reps[i] = 1;
    p.reps[8] = 0;
#ifdef REP_SYNC
    p.reps[8] = REP_SYNC;
#endif
#ifdef REP_SCAN
    p.reps[0] = REP_SCAN;
#endif
#ifdef REP_ATTN
    p.reps[1] = REP_ATTN;
#endif
#ifdef REP_PREP
    p.reps[2] = REP_PREP;
#endif
#ifdef REP_G1E
    p.reps[3] = REP_G1E;
#endif
#ifdef REP_G1O
    p.reps[4] = REP_G1O;
#endif
#ifdef REP_QKV
    p.reps[5] = REP_QKV;
#endif
#ifdef REP_OUT
    p.reps[6] = REP_OUT;
#endif
#ifdef REP_GLU
    p.reps[7] = REP_GLU;
#endif
    p.out = (float*)d_out;
    p.ws = (unsigned char*)d_ws;
    (void)hipMemsetAsync((unsigned char*)d_ws + OFF_BAR, 0, 16384, stream);
    void* args[] = {&p};
    hipError_t e = hipLaunchCooperativeKernel((const void*)fwd_megakernel, dim3(grid_blocks), dim3(512), args, LDS_BYTES, stream);
    if (e != hipSuccess) fprintf(stderr, "cooperative launch failed: %s (grid %d)\n", hipGetErrorString(e), grid_blocks);
}
```
